# Optimizing an MI355X kernel written in HIP

```python
import math
import jax, jax.numpy as jnp
from jax import lax
import numpy as np

D_MODEL = 1024
BATCH = 2
SEQ = 8192
DEPTH = 1
DEC_BATCH = 32
DEC_SEQ = 8
PAST_LEN = 8192
PAGE_SIZE = 128

N_META = 16
ATTN_HEADS = 4
HEAD_DIM = 64
V_DIM = 2 * HEAD_DIM
ATTN_WIDTH = ATTN_HEADS * V_DIM
CONV_WIDTH = D_MODEL - ATTN_WIDTH
QK_COLS = ATTN_HEADS * 2 * HEAD_DIM
IN_COLS = 2 * QK_COLS + ATTN_WIDTH + 3 * CONV_WIDTH
CONV_K = 3
D_FF = 2816
Q_BLOCK = 128
RMS_EPS = 1e-6
SUBLN_EPS = 1e-5
NEG_INF = -1e30

kernel_name = "hymba_diffattn_shortconv_macaron_step"


def rmsnorm(x, g, eps=RMS_EPS):
    xf = x.astype(jnp.float32)
    y = xf * lax.rsqrt(jnp.mean(xf * xf, axis=-1, keepdims=True) + eps) * g.astype(jnp.float32)
    return y.astype(x.dtype)


def swiglu(x, w_gate, w_up, w_down):
    return (jax.nn.silu(x @ w_gate) * (x @ w_up)) @ w_down


def diff_attend(q, k, v, q_pos, k_pos, lam):
    s = jnp.einsum('bqhcd,bkhcd->bhcqk', q.astype(jnp.float32), k.astype(jnp.float32)) * (HEAD_DIM ** -0.5)
    mask = k_pos[None, :] <= q_pos[:, None]
    s = jnp.where(mask, s, NEG_INF)
    p = jax.nn.softmax(s, axis=-1)
    a = p[:, :, 0] - lam * p[:, :, 1]
    return jnp.einsum('bhqk,bkhe->bqhe', a, v.astype(jnp.float32))


def attend_prompt(q, k, v, lam):
    b, t = q.shape[0], q.shape[1]
    s_len = t - N_META
    k_pos = jnp.arange(t)
    kf = k.astype(jnp.float32)
    vf = v.astype(jnp.float32)
    meta_pos = jnp.arange(N_META)
    o_meta = diff_attend(q[:, :N_META], kf[:, :N_META], vf[:, :N_META], meta_pos, meta_pos, lam)
    nb = s_len // Q_BLOCK
    q_blocks = jnp.moveaxis(q[:, N_META:].reshape(b, nb, Q_BLOCK, ATTN_HEADS, 2, HEAD_DIM), 1, 0)
    starts = N_META + jnp.arange(nb) * Q_BLOCK

    def one_block(args):
        qb, s0 = args
        return diff_attend(qb, kf, vf, s0 + jnp.arange(Q_BLOCK), k_pos, lam)

    o_real = lax.map(one_block, (q_blocks, starts))
    o_real = jnp.moveaxis(o_real, 0, 1).reshape(b, s_len, ATTN_HEADS, V_DIM)
    return jnp.concatenate([o_meta, o_real], axis=1)


def attend_sample(q, k, v, lam, k_past, v_past):
    past = k_past.shape[1]
    tq = q.shape[1]
    k_all = jnp.concatenate([k_past, k], axis=1)
    v_all = jnp.concatenate([v_past, v], axis=1)
    k_pos = jnp.arange(past + tq)
    q_pos = past + jnp.arange(tq)
    return diff_attend(q, k_all, v_all, q_pos, k_pos, lam)


def mixer(h, w_in, lq1, lk1, lq2, lk2, subln_g, conv_w, w_out, lambda_init, attend, conv_prev):
    b, t, _ = h.shape
    proj = h @ w_in
    q, k, v, gate_b, gate_c, hc = jnp.split(
        proj, [QK_COLS, 2 * QK_COLS, 2 * QK_COLS + ATTN_WIDTH,
               2 * QK_COLS + ATTN_WIDTH + CONV_WIDTH,
               2 * QK_COLS + ATTN_WIDTH + 2 * CONV_WIDTH], axis=-1)
    q = q.reshape(b, t, ATTN_HEADS, 2, HEAD_DIM)
    k = k.reshape(b, t, ATTN_HEADS, 2, HEAD_DIM)
    v = v.reshape(b, t, ATTN_HEADS, V_DIM)
    lam = (jnp.exp(jnp.sum(lq1.astype(jnp.float32) * lk1.astype(jnp.float32)))
           - jnp.exp(jnp.sum(lq2.astype(jnp.float32) * lk2.astype(jnp.float32))) + lambda_init)
    o = attend(q, k, v, lam)
    o = rmsnorm(o, subln_g, SUBLN_EPS) * (1.0 - lambda_init)
    o = o.reshape(b, t, ATTN_WIDTH).astype(h.dtype)
    u = gate_c * hc
    u_ext = jnp.concatenate([conv_prev.astype(u.dtype), u], axis=1)
    y = sum(conv_w[j] * u_ext[:, j:j + t] for j in range(CONV_K))
    c_out = gate_b * y
    out = jnp.concatenate([o, c_out], axis=-1) @ w_out
    return out, k, v, u_ext[:, -(CONV_K - 1):]


def layer(x, attend, conv_prev, lambda_init,
          f1_pre, f1_wg, f1_wu, f1_wd, f1_post,
          m_pre, w_in, lq1, lk1, lq2, lk2, subln_g, conv_w, w_out, m_post,
          f2_pre, f2_wg, f2_wu, f2_wd, f2_post):
    x = x + 0.5 * rmsnorm(swiglu(rmsnorm(x, f1_pre), f1_wg, f1_wu, f1_wd), f1_post)
    m, k, v, conv_new = mixer(rmsnorm(x, m_pre), w_in, lq1, lk1, lq2, lk2, subln_g, conv_w, w_out,
                              lambda_init, attend, conv_prev)
    x = x + rmsnorm(m, m_post)
    x = x + 0.5 * rmsnorm(swiglu(rmsnorm(x, f2_pre), f2_wg, f2_wu, f2_wd), f2_post)
    return x, k, v, conv_new


def setup_inputs(seed: int = 0) -> dict:
    key = jax.random.key(seed)
    ks = jax.random.split(key, 32)
    n_pages = PAST_LEN // PAGE_SIZE
    n_used = DEC_BATCH * n_pages
    n_pool = n_used + n_used // 4
    f32 = jnp.float32

    def nrm(k, shape, scale):
        return jax.random.normal(k, shape, f32) * scale

    def gain(k):
        return 1.0 + nrm(k, (DEPTH, D_MODEL), 0.05)

    page_table = jax.random.permutation(ks[0], n_pool)[:n_used].reshape(DEC_BATCH, n_pages).astype(jnp.int32)
    return {
        "x_prompt": nrm(ks[1], (BATCH, SEQ, D_MODEL), 1.0),
        "x_sample": nrm(ks[2], (DEC_BATCH, DEC_SEQ, D_MODEL), 1.0),
        "cache_k": nrm(ks[3], (DEPTH, n_pool, PAGE_SIZE, ATTN_HEADS, 2, HEAD_DIM), 1.0),
        "cache_v": nrm(ks[4], (DEPTH, n_pool, PAGE_SIZE, ATTN_HEADS, V_DIM), 1.0),
        "state_conv": nrm(ks[5], (DEPTH, DEC_BATCH, CONV_K - 1, CONV_WIDTH), 1.0),
        "page_table": page_table,
        "meta_tokens": nrm(ks[6], (N_META, D_MODEL), 1.0),
        "ffn1_pre_g": gain(ks[7]),
        "ffn1_w_gate": nrm(ks[8], (DEPTH, D_MODEL, D_FF), D_MODEL ** -0.5),
        "ffn1_w_up": nrm(ks[9], (DEPTH, D_MODEL, D_FF), D_MODEL ** -0.5),
        "ffn1_w_down": nrm(ks[10], (DEPTH, D_FF, D_MODEL), D_FF ** -0.5),
        "ffn1_post_g": gain(ks[11]),
        "mix_pre_g": gain(ks[12]),
        "w_in": nrm(ks[13], (DEPTH, D_MODEL, IN_COLS), D_MODEL ** -0.5),
        "lambda_q1": nrm(ks[14], (DEPTH, HEAD_DIM), 0.1),
        "lambda_k1": nrm(ks[15], (DEPTH, HEAD_DIM), 0.1),
        "lambda_q2": nrm(ks[16], (DEPTH, HEAD_DIM), 0.1),
        "lambda_k2": nrm(ks[17], (DEPTH, HEAD_DIM), 0.1),
        "subln_g": 1.0 + nrm(ks[18], (DEPTH, V_DIM), 0.05),
        "conv_w": nrm(ks[19], (DEPTH, CONV_K, CONV_WIDTH), CONV_K ** -0.5),
        "w_out": nrm(ks[20], (DEPTH, D_MODEL, D_MODEL), D_MODEL ** -0.5),
        "mix_post_g": gain(ks[21]),
        "ffn2_pre_g": gain(ks[22]),
        "ffn2_w_gate": nrm(ks[23], (DEPTH, D_MODEL, D_FF), D_MODEL ** -0.5),
        "ffn2_w_up": nrm(ks[24], (DEPTH, D_MODEL, D_FF), D_MODEL ** -0.5),
        "ffn2_w_down": nrm(ks[25], (DEPTH, D_FF, D_MODEL), D_FF ** -0.5),
        "ffn2_post_g": gain(ks[26]),
    }


def reference(x_prompt, x_sample, cache_k, cache_v, state_conv, page_table, meta_tokens,
              ffn1_pre_g, ffn1_w_gate, ffn1_w_up, ffn1_w_down, ffn1_post_g,
              mix_pre_g, w_in, lambda_q1, lambda_k1, lambda_q2, lambda_k2, subln_g, conv_w, w_out, mix_post_g,
              ffn2_pre_g, ffn2_w_gate, ffn2_w_up, ffn2_w_down, ffn2_post_g):
    b = x_prompt.shape[0]
    db, n_pages = page_table.shape
    past = n_pages * PAGE_SIZE
    meta = jnp.broadcast_to(meta_tokens.astype(x_prompt.dtype)[None], (b, N_META, D_MODEL))
    xp = jnp.concatenate([meta, x_prompt], axis=1)
    xs = x_sample
    kp_l, vp_l, cp_l, ks_l, vs_l, cs_l = [], [], [], [], [], []
    for l in range(DEPTH):
        lambda_init = 0.8 - 0.6 * math.exp(-0.3 * l)
        params = (ffn1_pre_g[l], ffn1_w_gate[l], ffn1_w_up[l], ffn1_w_down[l], ffn1_post_g[l],
                  mix_pre_g[l], w_in[l], lambda_q1[l], lambda_k1[l], lambda_q2[l], lambda_k2[l],
                  subln_g[l], conv_w[l], w_out[l], mix_post_g[l],
                  ffn2_pre_g[l], ffn2_w_gate[l], ffn2_w_up[l], ffn2_w_down[l], ffn2_post_g[l])
        conv0 = jnp.zeros((b, CONV_K - 1, CONV_WIDTH), xp.dtype)
        xp, kp, vp, cp = layer(xp, attend_prompt, conv0, lambda_init, *params)
        k_past = cache_k[l][page_table].reshape(db, past, ATTN_HEADS, 2, HEAD_DIM)
        v_past = cache_v[l][page_table].reshape(db, past, ATTN_HEADS, V_DIM)
        att_s = lambda q, k, v, lam, kp_=k_past, vp_=v_past: attend_sample(q, k, v, lam, kp_, vp_)
        xs, ksn, vsn, csn = layer(xs, att_s, state_conv[l], lambda_init, *params)
        kp_l.append(kp); vp_l.append(vp); cp_l.append(cp)
        ks_l.append(ksn); vs_l.append(vsn); cs_l.append(csn)
    y_prompt = xp[:, N_META:]
    y_sample = xs
    k_prompt_new = jnp.stack(kp_l)
    v_prompt_new = jnp.stack(vp_l)
    conv_prompt_new = jnp.stack(cp_l)
    k_sample_new = jnp.stack(ks_l)
    v_sample_new = jnp.stack(vs_l)
    conv_sample_new = jnp.stack(cs_l)
    return (y_prompt, y_sample, k_prompt_new, v_prompt_new, conv_prompt_new, k_sample_new, v_sample_new, conv_sample_new)
```

```cpp
#include <hip/hip_runtime.h>
#include <cstdio>
#include <cstdint>
namespace pg8 {
#define PG8_LAS __attribute__((address_space(3)))
typedef unsigned short bf16_t;
typedef short bf16x8 __attribute__((ext_vector_type(8)));
typedef float f32x4 __attribute__((ext_vector_type(4)));
typedef unsigned u32x4 __attribute__((ext_vector_type(4)));
constexpr int BM = 256, BK = 64, HALF = 128, HTB = HALF * BK * 2  , STAGE_BYTES = 8 * HTB, NXCD = 8, WGM = 8;

__host__ __device__ __forceinline__ int lds_byte(int r, int c) { const int st = (r >> 4) * 2 + (c >> 5), rr = r & 15, cc = c & 31, ob = rr * 64 + cc * 2; return st * 1024 + (ob ^ (((ob >> 9) & 1) << 5)); }
__host__ __device__ __forceinline__ void stage_rc(int b, int& R, int& C) { const int st = b / 1024, sb = b % 1024, swz = sb ^ (((sb >> 9) & 1) << 5); R = (st >> 1) * 16 + swz / 64; C = (st & 1) * 32 + (swz % 64) / 2; }
__host__ __device__ __forceinline__ int perm32(int rho) { const int n = rho >> 4, i = rho & 15; return 8 * (i >> 2) + 4 * n + (i & 3); }

struct Unit { int pm, pn; };
struct Gemm { const bf16_t* A; const bf16_t* Bt; int M, N, K; };

struct StaticOrder {
    int nM, nN, nwg, G, c;
    __host__ __device__ void init(int M, int N, int G_, int c_) { nM = M / BM; nN = N / BM; nwg = nM * nN; G = G_; c = c_; }
    __host__ __device__ bool next(int i, Unit& u) const {
        const long L = (long)i * G + c; if (L >= nwg) return false;
        int wgid = (int)L; { const int q = nwg / NXCD, r = nwg % NXCD, xcd = wgid % NXCD, off = wgid / NXCD; wgid = (xcd < r ? xcd * (q + 1) : r * (q + 1) + (xcd - r) * q) + off; }
        const int nig = WGM * nN, gid = wgid / nig, fm = gid * WGM, gsz = (nM - fm) < WGM ? (nM - fm) : WGM;
        u.pm = fm + ((wgid % nig) % gsz); u.pn = (wgid % nig) / gsz; return true;
    }
    __device__ __forceinline__ void a_ready(const Unit&) const {}
    __device__ __forceinline__ void done(const Unit&) const {}
};

__device__ __forceinline__ unsigned cvt_pk_bf16(float lo, float hi) { unsigned r; asm volatile("v_cvt_pk_bf16_f32 %0, %1, %2" : "=v"(r) : "v"(lo), "v"(hi)); return r; }
__device__ __forceinline__ float silu_f(float g) { return g * __builtin_amdgcn_rcpf(1.0f + __builtin_amdgcn_exp2f(-1.4426950408889634f * g)); }

struct EpiSwiGLU {
    static constexpr bool PERM = true, AFTER_DRAIN = false;
    bf16_t* O; int ldc;
    __device__ __forceinline__ void operator()(const f32x4 (&acc)[2][2][4][2], const Unit& u, int wr, int wc, int fr, int fq) const {
        const int row0 = u.pm * BM + wr * 64 + fr, col0 = u.pn * HALF + wc * 32 + 8 * fq;
#pragma unroll
        for (int ai = 0; ai < 2; ++ai)
#pragma unroll
            for (int m = 0; m < 4; ++m) {
                bf16_t* rowp = O + (size_t)(row0 + ai * HALF + m * 16) * ldc + col0;
                const f32x4 g0 = acc[ai][0][m][0], g1 = acc[ai][0][m][1], u0 = acc[ai][1][m][0], u1 = acc[ai][1][m][1];
                u32x4 w;
                w.x = cvt_pk_bf16(silu_f(g0[0]) * u0[0], silu_f(g0[1]) * u0[1]); w.y = cvt_pk_bf16(silu_f(g0[2]) * u0[2], silu_f(g0[3]) * u0[3]);
                w.z = cvt_pk_bf16(silu_f(g1[0]) * u1[0], silu_f(g1[1]) * u1[1]); w.w = cvt_pk_bf16(silu_f(g1[2]) * u1[2], silu_f(g1[3]) * u1[3]);
                *(u32x4*)rowp = w;
            }
    }
};
struct EpiF32 {
    static constexpr bool PERM = false, AFTER_DRAIN = false;
    float* O; int ldc;
    __device__ __forceinline__ void operator()(const f32x4 (&acc)[2][2][4][2], const Unit& u, int wr, int wc, int fr, int fq) const {
        const int col0 = u.pn * BM + wc * 32 + 4 * fq;
#pragma unroll
        for (int ai = 0; ai < 2; ++ai)
#pragma unroll
            for (int m = 0; m < 4; ++m) { float* rowp = O + (size_t)(u.pm * BM + ai * HALF + wr * 64 + m * 16 + fr) * ldc + col0;
#pragma unroll
                for (int bj = 0; bj < 2; ++bj)
#pragma unroll
                    for (int n = 0; n < 2; ++n) *(f32x4*)(rowp + bj * HALF + n * 16) = acc[ai][bj][m][n]; }
    }
};
struct EpiWin {
    static constexpr bool PERM = true, AFTER_DRAIN = false;
    bf16_t *QB, *KB, *VB, *GB, *UB; float *OUTK, *OUTV, *OUTC; float qscale;
    __device__ __forceinline__ void operator()(const f32x4 (&acc)[2][2][4][2], const Unit& u, int wr, int wc, int fr, int fq) const {
        const int pn = u.pn, c8 = wc * 32 + 8 * fq;
#pragma unroll
        for (int ai = 0; ai < 2; ++ai)
#pragma unroll
            for (int m = 0; m < 4; ++m) {
                const int row = u.pm * BM + ai * HALF + wr * 64 + m * 16 + fr, b = row >> 13, s = row & 8191;
                if (pn >= 8) {
                    const f32x4 a0 = acc[ai][0][m][0] * acc[ai][1][m][0], a1 = acc[ai][0][m][1] * acc[ai][1][m][1];
                    const int col = (pn - 8) * HALF + c8;
                    u32x4 w; w.x = cvt_pk_bf16(a0[0], a0[1]); w.y = cvt_pk_bf16(a0[2], a0[3]); w.z = cvt_pk_bf16(a1[0], a1[1]); w.w = cvt_pk_bf16(a1[2], a1[3]);
                    *(u32x4*)(UB + (size_t)row * 512 + col) = w;
                    if (s >= 8190) { float* o = OUTC + (size_t)(b * 2 + (s - 8190)) * 512 + col; *(f32x4*)o = a0; *(f32x4*)(o + 4) = a1; }
                } else {
#pragma unroll
                    for (int bj = 0; bj < 2; ++bj) {
                        const f32x4 a0 = acc[ai][bj][m][0], a1 = acc[ai][bj][m][1];
                        const int col = (pn & 1) * BM + bj * HALF + c8;
                        if (pn < 2) { const f32x4 q0 = a0 * qscale, q1 = a1 * qscale; u32x4 w; w.x = cvt_pk_bf16(q0[0], q0[1]); w.y = cvt_pk_bf16(q0[2], q0[3]); w.z = cvt_pk_bf16(q1[0], q1[1]); w.w = cvt_pk_bf16(q1[2], q1[3]);
                            *(u32x4*)(QB + (size_t)row * 512 + col) = w; }
                        else { u32x4 w; w.x = cvt_pk_bf16(a0[0], a0[1]); w.y = cvt_pk_bf16(a0[2], a0[3]); w.z = cvt_pk_bf16(a1[0], a1[1]); w.w = cvt_pk_bf16(a1[2], a1[3]);
                            if (pn < 6) { bf16_t* kb = (pn < 4) ? KB : VB; float* of = (pn < 4) ? OUTK : OUTV;
                                *(u32x4*)(kb + (size_t)row * 512 + col) = w;
                                float* o = of + (size_t)(b * 8208 + 16 + s) * 512 + col; *(f32x4*)o = a0; *(f32x4*)(o + 4) = a1; }
                            else *(u32x4*)(GB + (size_t)row * 512 + col) = w; }
                    }
                }
            }
    }
};
template <class Epi, class Sched, bool ALIGN_EPI = false, bool SP2 = false>
__device__ __forceinline__ void gemm_phase(PG8_LAS unsigned char* lds, const Gemm g, const Sched& S, const Epi& E) {
    const int tid = threadIdx.x, wid = __builtin_amdgcn_readfirstlane(tid >> 6), lane = tid & 63, wr = wid >> 2, wc = wid & 3, fr = lane & 15, fq = lane >> 4;
    const int K = g.K, nt = K / BK;
    unsigned voffA[2], voffB[2];
#pragma unroll
    for (int i = 0; i < 2; ++i) { int R, C; stage_rc(tid * 16 + i * 8192, R, C); const int Rb = Epi::PERM ? ((R & ~31) + perm32(R & 31)) : R;
        voffA[i] = (unsigned)(R * K + C) * 2u; voffB[i] = (unsigned)(Rb * K + C) * 2u; }
    const size_t kstep = (size_t)(BK * 2);
    const size_t hstep = (size_t)HALF * K * 2;
    const size_t tstep = 2 * hstep;
    const unsigned ldsw = (unsigned)wid * 1024u;
    const int aoff = lds_byte(wr * 64 + fr, fq * 8), boff = lds_byte(wc * 32 + fr, fq * 8);
#define PG8_SA(b, h) (((b) * 2 + (h)) * HTB)
#define PG8_SB(b, h) ((4 + (b) * 2 + (h)) * HTB)
#define PG8_STAGE(bufoff, gbase, voff) do { _Pragma("unroll") for (int _i = 0; _i < 2; ++_i) \
        __builtin_amdgcn_global_load_lds((const unsigned*)((const char*)(gbase) + (voff)[_i]), (PG8_LAS unsigned*)(lds + (bufoff) + ldsw + _i * 8192), 16, 0, 0); } while (0)
#define PG8_LDA(dst, b, h) do { _Pragma("unroll") for (int m = 0; m < 4; ++m) _Pragma("unroll") for (int k = 0; k < 2; ++k) dst[m][k] = *(const PG8_LAS bf16x8*)(lds + PG8_SA(b, h) + aoff + m * 2048 + k * 1024); } while (0)
#define PG8_LDB(dst, b, h) do { _Pragma("unroll") for (int n = 0; n < 2; ++n) _Pragma("unroll") for (int k = 0; k < 2; ++k) dst[n][k] = *(const PG8_LAS bf16x8*)(lds + PG8_SB(b, h) + boff + n * 2048 + k * 1024); } while (0)
#define PG8_MMA(ai, bj, At, Bt) do { __builtin_amdgcn_s_setprio(1); _Pragma("unroll") for (int m = 0; m < 4; ++m) _Pragma("unroll") for (int n = 0; n < 2; ++n) _Pragma("unroll") for (int k = 0; k < 2; ++k) \
        acc[ai][bj][m][n] = __builtin_amdgcn_mfma_f32_16x16x32_bf16(Bt[n][k], At[m][k], acc[ai][bj][m][n], 0, 0, 0); __builtin_amdgcn_s_setprio(0); } while (0)
#define PG8_WAIT_V(n) asm volatile("s_waitcnt vmcnt(" #n ")" ::: "memory")
#define PG8_WAIT_L(n) asm volatile("s_waitcnt lgkmcnt(" #n ")" ::: "memory")
#define PG8_BAR __builtin_amdgcn_s_barrier()
#define PG8_SCHED __builtin_amdgcn_sched_barrier(0)
    Unit cur, nxt; int ui = 0;
    if (!S.next(0, cur)) return;
    f32x4 acc[2][2][4][2];
#pragma unroll
    for (int a = 0; a < 2; ++a)
#pragma unroll
        for (int b = 0; b < 2; ++b)
#pragma unroll
            for (int m = 0; m < 4; ++m)
#pragma unroll
                for (int n = 0; n < 2; ++n) acc[a][b][m][n] = (f32x4){0.f, 0.f, 0.f, 0.f};
    bf16x8 At[4][2], B0[2][2], B1[2][2];
    const char* cA = (const char*)g.A + (size_t)cur.pm * tstep; const char* cB = (const char*)g.Bt + (size_t)cur.pn * tstep;
    S.a_ready(cur);
    if constexpr (SP2) {
        PG8_STAGE(PG8_SB(0, 0), cB, voffB); PG8_STAGE(PG8_SB(0, 1), cB + hstep, voffB); PG8_STAGE(PG8_SA(0, 0), cA, voffA); PG8_STAGE(PG8_SA(0, 1), cA + hstep, voffA);
        if (wr == 1) PG8_BAR;
        PG8_WAIT_V(2); PG8_BAR;
        PG8_STAGE(PG8_SB(1, 0), cB + kstep, voffB); PG8_STAGE(PG8_SA(1, 0), cA + kstep, voffA); PG8_STAGE(PG8_SB(1, 1), cB + hstep + kstep, voffB);
        PG8_WAIT_V(6); PG8_BAR;
    } else {
        PG8_STAGE(PG8_SB(0, 0), cB, voffB); PG8_STAGE(PG8_SA(0, 0), cA, voffA); PG8_STAGE(PG8_SB(0, 1), cB + hstep, voffB); PG8_STAGE(PG8_SA(0, 1), cA + hstep, voffA);
        if (wr == 1) PG8_BAR;
        PG8_WAIT_V(4); PG8_BAR;
        PG8_STAGE(PG8_SB(1, 0), cB + kstep, voffB); PG8_STAGE(PG8_SA(1, 0), cA + kstep, voffA); PG8_STAGE(PG8_SB(1, 1), cB + hstep + kstep, voffB);
        PG8_WAIT_V(6); PG8_BAR;
    }
    for (;;) {
        const bool has_next = S.next(ui + 1, nxt);
        const char* nA = has_next ? (const char*)g.A + (size_t)nxt.pm * tstep : cA; const char* nB = has_next ? (const char*)g.Bt + (size_t)nxt.pn * tstep : cB;
        for (int t = 0; t < nt; t += 2) {
            const bool last = (t == nt - 2);
            const char* a1 = cA + (size_t)(t + 1) * kstep;
            const char* a2 = last ? nA : cA + (size_t)(t + 2) * kstep; const char* b2 = last ? nB : cB + (size_t)(t + 2) * kstep;
            const char* a3 = a2 + kstep; const char* b3 = b2 + kstep;
            if (last && has_next) S.a_ready(nxt);
            if constexpr (SP2) {
            PG8_LDB(B0, 0, 0); PG8_LDB(B1, 0, 1); PG8_SCHED; PG8_LDA(At, 0, 0); PG8_STAGE(PG8_SA(1, 1), a1 + hstep, voffA);
            PG8_WAIT_V(8); PG8_WAIT_L(0); PG8_BAR; PG8_MMA(0, 0, At, B0); PG8_MMA(0, 1, At, B1); PG8_BAR; PG8_SCHED;
            PG8_LDA(At, 0, 1); PG8_STAGE(PG8_SB(0, 0), b2, voffB); PG8_STAGE(PG8_SB(0, 1), b2 + hstep, voffB); PG8_STAGE(PG8_SA(0, 0), a2, voffA);
            PG8_WAIT_V(8); PG8_WAIT_L(0); PG8_BAR; PG8_MMA(1, 0, At, B0); PG8_MMA(1, 1, At, B1); PG8_BAR; PG8_SCHED;
            PG8_LDB(B0, 1, 0); PG8_LDB(B1, 1, 1); PG8_SCHED; PG8_LDA(At, 1, 0); PG8_STAGE(PG8_SA(0, 1), a2 + hstep, voffA);
            PG8_WAIT_V(8); PG8_WAIT_L(0); PG8_BAR; PG8_MMA(0, 0, At, B0); PG8_MMA(0, 1, At, B1); PG8_BAR; PG8_SCHED;
            PG8_LDA(At, 1, 1); PG8_STAGE(PG8_SB(1, 0), b3, voffB); PG8_STAGE(PG8_SB(1, 1), b3 + hstep, voffB); PG8_STAGE(PG8_SA(1, 0), a3, voffA);
            PG8_WAIT_V(8); PG8_WAIT_L(0); PG8_BAR; PG8_MMA(1, 0, At, B0); PG8_MMA(1, 1, At, B1); PG8_BAR; PG8_SCHED;
            } else {
            PG8_LDB(B0, 0, 0); PG8_SCHED; PG8_LDA(At, 0, 0); PG8_STAGE(PG8_SA(1, 1), a1 + hstep, voffA);
            PG8_WAIT_L(8); PG8_BAR; PG8_WAIT_L(0); PG8_MMA(0, 0, At, B0); PG8_BAR; PG8_SCHED;
            PG8_LDB(B1, 0, 1); PG8_STAGE(PG8_SB(0, 0), b2, voffB);
            PG8_BAR; PG8_WAIT_L(0); PG8_MMA(0, 1, At, B1); PG8_BAR;
            PG8_LDA(At, 0, 1); PG8_STAGE(PG8_SA(0, 0), a2, voffA);
            PG8_BAR; PG8_WAIT_L(0); PG8_MMA(1, 0, At, B0); PG8_BAR; PG8_SCHED;
            PG8_STAGE(PG8_SB(0, 1), b2 + hstep, voffB);
            PG8_WAIT_V(6); PG8_BAR; PG8_MMA(1, 1, At, B1); PG8_BAR;
            PG8_LDB(B0, 1, 0); PG8_SCHED; PG8_LDA(At, 1, 0); PG8_STAGE(PG8_SA(0, 1), a2 + hstep, voffA);
            PG8_WAIT_L(8); PG8_BAR; PG8_WAIT_L(0); PG8_MMA(0, 0, At, B0); PG8_BAR; PG8_SCHED;
            PG8_LDB(B1, 1, 1); PG8_STAGE(PG8_SB(1, 0), b3, voffB);
            PG8_BAR; PG8_WAIT_L(0); PG8_MMA(0, 1, At, B1); PG8_BAR;
            PG8_LDA(At, 1, 1); PG8_STAGE(PG8_SA(1, 0), a3, voffA);
            PG8_BAR; PG8_WAIT_L(0); PG8_MMA(1, 0, At, B0); PG8_BAR; PG8_SCHED;
            PG8_STAGE(PG8_SB(1, 1), b3 + hstep, voffB);
            PG8_WAIT_V(6); PG8_BAR; PG8_MMA(1, 1, At, B1); PG8_BAR;
            }
        }
        if constexpr (ALIGN_EPI) { if (wr == 0) PG8_BAR; }
        if constexpr (!Epi::AFTER_DRAIN) { E(acc, cur, wr, wc, fr, fq); S.done(cur); }
        if (!has_next) break;
#pragma unroll
        for (int a = 0; a < 2; ++a)
#pragma unroll
            for (int b = 0; b < 2; ++b)
#pragma unroll
                for (int m = 0; m < 4; ++m)
#pragma unroll
                    for (int n = 0; n < 2; ++n) acc[a][b][m][n] = (f32x4){0.f, 0.f, 0.f, 0.f};
        cur = nxt; cA = nA; cB = nB; ++ui;
        if constexpr (ALIGN_EPI) { if (wr == 1) PG8_BAR; }
    }
    PG8_WAIT_V(0);
    if constexpr (!ALIGN_EPI) { if (wr == 0) PG8_BAR; }
    PG8_BAR;
    if constexpr (Epi::AFTER_DRAIN) { E.fused(acc, cur, wr, wc, fr, fq, lds, wid, lane); S.done(cur); }
#undef PG8_SA
#undef PG8_SB
#undef PG8_STAGE
#undef PG8_LDA
#undef PG8_LDB
#undef PG8_MMA
#undef PG8_WAIT_V
#undef PG8_WAIT_L
#undef PG8_BAR
#undef PG8_SCHED
}
}

#ifndef PG8_SP2
#define PG8_SP2 true
#endif
#ifndef PG8_ALIGN
#define PG8_ALIGN true
#endif
#include <hip/hip_bf16.h>
#include <cmath>
namespace attn_body {
using bf16=__hip_bfloat16;
using bf16x8=__attribute__((ext_vector_type(8)))short;
using s16x4=__attribute__((ext_vector_type(4)))short;
using f32x16=__attribute__((ext_vector_type(16)))float;
using u32x4=__attribute__((ext_vector_type(4)))unsigned;
constexpr int SEQ=8192,D=64,DM=512;
constexpr int NW=8,QBLK=32,QB=QBLK*NW,KVBLK=64,NQB=SEQ/QB;
constexpr int ATTN_PITCH=DM, ATTN_UNIT_ROWS=QB;
__device__ __forceinline__ int crow(int r,int hi){return (r&3)+8*(r>>2)+4*hi;}
#define SBAR() __builtin_amdgcn_sched_barrier(0)
__device__ __forceinline__ void cmask(f32x16&p0,f32x16&p1,int jb,int qrel,int hi){
  const float NEG=-INFINITY; int kb=64*jb+4*hi;
  #pragma unroll
  for(int r=0;r<16;++r){int kv=kb+(r&3)+8*(r>>2); if(kv>qrel)p0[r]=NEG; if(kv+32>qrel)p1[r]=NEG;}
}

constexpr int NSLOT=3, SLOTB=8192;
constexpr int LDS_K=0, LDS_V=NSLOT*SLOTB, LDS_WS=2*NSLOT*SLOTB, LDS_OST=LDS_WS+NW*64*4, LDS_HK=LDS_OST+NW*4096, LDS_HV=LDS_HK+SLOTB, LDS_BYTES=LDS_HV+SLOTB;
constexpr float C2=0.125f*1.4426950408889634f;
__device__ __forceinline__ void glds16(const void*gsrc,unsigned lds_dst){unsigned keep;
  asm volatile("s_mov_b32 %0, m0\n\ts_mov_b32 m0, %2\n\ts_nop 0\n\tglobal_load_lds_dwordx4 %1, off\n\ts_mov_b32 m0, %0":"=&s"(keep):"v"(gsrc),"s"(lds_dst):"memory");}
__device__ __forceinline__ float max3f(float a,float b,float c){float r;asm("v_max3_f32 %0, %1, %2, %3":"=v"(r):"v"(a),"v"(b),"v"(c));return r;}
__device__ __forceinline__ float max2f(float a,float b){float r;asm("v_max_f32_e32 %0, %1, %2":"=v"(r):"v"(a),"v"(b));return r;}
__device__ __forceinline__ float fadd_s(float a,float b){float r;asm("v_add_f32_e32 %0, %1, %2":"=v"(r):"v"(a),"v"(b));return r;}
__device__ __forceinline__ float fsub_s(float a,float b){float r;asm("v_sub_f32_e32 %0, %1, %2":"=v"(r):"v"(a),"v"(b));return r;}
typedef float f32x2_t __attribute__((ext_vector_type(2))); typedef __bf16 bf16x2_t __attribute__((ext_vector_type(2)));
__device__ __forceinline__ unsigned cvtpk_s(float lo,float hi){f32x2_t v={lo,hi};bf16x2_t b=__builtin_convertvector(v,bf16x2_t);return __builtin_bit_cast(unsigned,b);}
#define WAIT_BAR(N) asm volatile("s_waitcnt vmcnt(" #N ") lgkmcnt(0)\n\ts_barrier":::"memory")

__device__ __forceinline__ void hmask(f32x16&p0,f32x16&p1){ const float NEG=-INFINITY;
  #pragma unroll
  for(int r=0;r<16;++r){ if(r>=8)p0[r]=NEG; p1[r]=NEG; } }
__device__ __forceinline__ void qkt(f32x16&p0,f32x16&p1,const char*Kslot,const bf16x8*qr,const f32x16&negm,int r32,int hi){
  const char*kb=Kslot+hi*1024+r32*16;
  #pragma unroll
  for(int d0=0;d0<4;++d0){
    const bf16x8 b0=*reinterpret_cast<const bf16x8*>(kb+d0*2048);
    const bf16x8 b1=*reinterpret_cast<const bf16x8*>(kb+d0*2048+512);
    if(d0==0){p0=__builtin_amdgcn_mfma_f32_32x32x16_bf16(b0,qr[0],negm,0,0,0);p1=__builtin_amdgcn_mfma_f32_32x32x16_bf16(b1,qr[0],negm,0,0,0);}
    else{p0=__builtin_amdgcn_mfma_f32_32x32x16_bf16(b0,qr[d0],p0,0,0,0);p1=__builtin_amdgcn_mfma_f32_32x32x16_bf16(b1,qr[d0],p1,0,0,0);}}
}
typedef __attribute__((address_space(3))) const char* lds_cptr;
typedef short v4i16_t __attribute__((ext_vector_type(4)));
__device__ __forceinline__ void kload8(bf16x8*kf,lds_cptr kp){
  kf[0]=*(const __attribute__((address_space(3))) bf16x8*)(kp);      kf[1]=*(const __attribute__((address_space(3))) bf16x8*)(kp+512);
  kf[2]=*(const __attribute__((address_space(3))) bf16x8*)(kp+2048); kf[3]=*(const __attribute__((address_space(3))) bf16x8*)(kp+2560);
  kf[4]=*(const __attribute__((address_space(3))) bf16x8*)(kp+4096); kf[5]=*(const __attribute__((address_space(3))) bf16x8*)(kp+4608);
  kf[6]=*(const __attribute__((address_space(3))) bf16x8*)(kp+6144); kf[7]=*(const __attribute__((address_space(3))) bf16x8*)(kp+6656);
}
__device__ __forceinline__ void kload2(bf16x8*kf,lds_cptr kp,int j){ kf[2*j]=*(const __attribute__((address_space(3))) bf16x8*)(kp+j*2048); kf[2*j+1]=*(const __attribute__((address_space(3))) bf16x8*)(kp+j*2048+512); }
__device__ __forceinline__ s16x4 vtr(lds_cptr p){ return __builtin_bit_cast(s16x4,__builtin_amdgcn_ds_read_tr16_b64_v4i16((__attribute__((address_space(3))) v4i16_t*)p)); }
__device__ __forceinline__ float rowmax(const f32x16&p0,const f32x16&p1){
  float a=max3f(p0[0],p0[1],p1[0]),b=max3f(p0[2],p0[3],p1[1]);a=max3f(a,p1[2],p1[3]);
  #pragma unroll
  for(int r=4;r<16;r+=4){a=max3f(a,p0[r],p0[r+1]);b=max3f(b,p0[r+2],p0[r+3]);a=max3f(a,p1[r],p1[r+1]);b=max3f(b,p1[r+2],p1[r+3]);}
  const float m=max2f(a,b);
  auto rr=__builtin_amdgcn_permlane32_swap(__float_as_uint(m),__float_as_uint(m),false,false);
  return max2f(__uint_as_float(rr[0]),__uint_as_float(rr[1]));
}
__device__ __forceinline__ void pv(f32x16*o,int vb,bf16x8 pa0,bf16x8 pa1,bf16x8 pa2,bf16x8 pa3){
  #pragma unroll
  for(int d0=0;d0<2;++d0){s16x4 lo[4],hi[4];
    #pragma unroll
    for(int ks=0;ks<4;++ks){
      asm volatile("ds_read_b64_tr_b16 %0,%1 offset:%c2":"=&v"(lo[ks]):"v"(vb),"i"(d0*4096+ks*1024):"memory");
      asm volatile("ds_read_b64_tr_b16 %0,%1 offset:%c2":"=&v"(hi[ks]):"v"(vb),"i"(d0*4096+ks*1024+512):"memory");}
    asm volatile("s_waitcnt lgkmcnt(0)":::"memory");SBAR();
    #define PK(k) (bf16x8){lo[k][0],lo[k][1],lo[k][2],lo[k][3],hi[k][0],hi[k][1],hi[k][2],hi[k][3]}
    o[d0]=__builtin_amdgcn_mfma_f32_32x32x16_bf16(pa0,PK(0),o[d0],0,0,0);
    o[d0]=__builtin_amdgcn_mfma_f32_32x32x16_bf16(pa1,PK(1),o[d0],0,0,0);
    o[d0]=__builtin_amdgcn_mfma_f32_32x32x16_bf16(pa2,PK(2),o[d0],0,0,0);
    o[d0]=__builtin_amdgcn_mfma_f32_32x32x16_bf16(pa3,PK(3),o[d0],0,0,0);
    #undef PK
  }
}

#ifndef ATTN_STORE16
#define ATTN_STORE16(p,v) (*(u32x4*)(p)=(v))
#endif
template<int THRL> __device__ __forceinline__ void attn_unit(int qb,const bf16*Qu,const bf16*__restrict__ Ku,const bf16*__restrict__ Vu,const bf16*__restrict__ KHu,const bf16*__restrict__ VHu,bf16*Ou,char*shm){
  const int tid=threadIdx.x,lane=tid&63,r32=lane&31,hi=lane>>5; const int wid=__builtin_amdgcn_readfirstlane(tid>>6);
  const int q0=qb*QB;
  const bf16*Qw=Qu+(long)(q0+wid*QBLK)*DM;
  const bf16*Kh=Ku,*Vh=Vu;
  const unsigned lds0=(unsigned)(uintptr_t)shm;
  float*wsf=(float*)(shm+LDS_WS)+wid*64;
  const bf16*ksrc=Kh+(long)lane*DM+wid*8;
  const bf16*vsrc=Vh+(long)(16*(wid&3)+(lane>>2))*DM+(wid>>2)*32+(lane&3)*8;
  const unsigned kdst=lds0+LDS_K+wid*1024, vdst=lds0+LDS_V+wid*1024;
  #define DMA_K(t,slot) glds16(ksrc+(long)(t)*KVBLK*DM,(unsigned)__builtin_amdgcn_readfirstlane(kdst+(slot)))
  #define DMA_V(t,slot) glds16(vsrc+(long)(t)*KVBLK*DM,(unsigned)__builtin_amdgcn_readfirstlane(vdst+(slot)))
  const int vb0=(int)(lds0+LDS_V)+((lane>>4)&1)*32+(lane&3)*8+(4*hi+((lane&15)>>2))*64;
  const char*Kbase=shm+LDS_K; bf16x8 kf[8];
  const lds_cptr shm3=(lds_cptr)shm; const lds_cptr kp0=shm3+LDS_K+hi*1024+r32*16; const lds_cptr vp0=shm3+LDS_V+((lane>>4)&1)*32+(lane&3)*8+(4*hi+((lane&15)>>2))*64;
  const int NT=(q0+QB)/KVBLK;
  glds16(KHu+(long)lane*DM+wid*8,(unsigned)__builtin_amdgcn_readfirstlane(lds0+LDS_HK+wid*1024));
  glds16(VHu+(long)(16*(wid&3)+(lane>>2))*DM+(wid>>2)*32+(lane&3)*8,(unsigned)__builtin_amdgcn_readfirstlane(lds0+LDS_HV+wid*1024));
  DMA_K(0,0);DMA_V(0,0);DMA_K(1,SLOTB);
  bf16x8 qr[4];
  #pragma unroll
  for(int d0=0;d0<4;++d0)qr[d0]=*reinterpret_cast<const bf16x8*>(&Qw[(long)r32*DM+d0*16+hi*8]);
  float mhat=0.f,l_reg=0.f;f32x16 o[2];o[0]=f32x16{};o[1]=f32x16{};f32x16 negm=f32x16{};asm volatile("":"+v"(negm));
  const int qrel=wid*QBLK+r32;
  #define CMASK(P0,P1,t) do{int jb_=(t)-(NT-4); if(jb_>=0)cmask(P0,P1,jb_,qrel,hi);}while(0)
  bool resc=false;
  #define START(P0,P1) do{ const float rm=rowmax(P0,P1); resc=false; \
    { const float dl=rm; mhat=fadd_s(mhat,dl); \
      _Pragma("unroll") for(int r=0;r<16;++r){P0[r]=fsub_s(P0[r],dl);P1[r]=fsub_s(P1[r],dl);} \
      _Pragma("unroll") for(int r=0;r<16;++r)negm[r]=-mhat; asm volatile("":"+v"(negm)); } \
    _Pragma("unroll") for(int r=0;r<16;++r)P0[r]=__builtin_amdgcn_exp2f(P0[r]); }while(0)
  #define RESC() do{ if(resc){ asm volatile("s_waitcnt lgkmcnt(0)":::"memory"); \
      _Pragma("unroll") for(int d_=0;d_<2;++d_) _Pragma("unroll") for(int r=0;r<16;++r)o[d_][r]*=wsf[crow(r,hi)]; } }while(0)
  f32x16 pA0,pA1,pB0,pB1;
  int sl_prev=0,sl_cur=0,sl_next=SLOTB;
  #define ROT() do{sl_prev=sl_cur;sl_cur=sl_next;sl_next=(sl_next==(NSLOT-1)*SLOTB)?0:sl_next+SLOTB;}while(0)
  DMA_K(2,2*SLOTB);
  WAIT_BAR(3);
  qkt(pA0,pA1,Kbase,qr,negm,r32,hi);asm volatile("s_nop 15\n\ts_nop 7":"+v"(pA0),"+v"(pA1));CMASK(pA0,pA1,0);
  START(pA0,pA1);
  _Pragma("unroll") for(int r=0;r<16;++r)pA1[r]=__builtin_amdgcn_exp2f(pA1[r]);
  WAIT_BAR(0);
  DMA_K(3,0);DMA_V(1,SLOTB);
  ROT();
  kload8(kf,kp0+sl_cur);
  WAIT_BAR(2);
  s16x4 vlo[8],vhi[8]; u32x4 pw0,pw1,pw2,pw3;
  #define PKW(P,B) cvtpk_s(P[B],P[B+1])
  #define PAF(k) __builtin_bit_cast(bf16x8,pw##k)
  #define VFR(i) (bf16x8){vlo[i][0],vlo[i][1],vlo[i][2],vlo[i][3],vhi[i][0],vhi[i][1],vhi[i][2],vhi[i][3]}
  #define PIN(x) asm volatile("":"+v"(x))
  #define MX3(a,b,c) __builtin_fmaxf(__builtin_fmaxf((a),(b)),(c))
  #define GAPA(MF,A0,A1,A2,A3,W0,W1,PW) do{ MF; sacc+=A0; sacc+=A1; sacc+=A2; sacc+=A3; PIN(sacc); W0; W1; PIN(PW); SBAR(); }while(0)
  #define EX(v) __builtin_amdgcn_exp2f(v)
  #define GAPB(MF,X,B) do{ MF; X[B]=EX(X[B]); X[B+1]=EX(X[B+1]); X[B+2]=EX(X[B+2]); X[B+3]=EX(X[B+3]); PIN(X); SBAR(); }while(0)
  #define VRD(i) do{ vlo[i]=vtr(vp_+(((i)>>2)*4096+((i)&3)*1024)); vhi[i]=vtr(vp_+(((i)>>2)*4096+((i)&3)*1024+512)); }while(0)
  #define KRD(G,j) do{ if(G){ kload2(kf,kp0+sl_next,j); SBAR(); } }while(0)
  #define STEP(C0,C1,P0,P1,t,GK,GV,GL) do{ SBAR(); \
    const lds_cptr vp_=vp0+sl_prev; \
    VRD(0); SBAR(); float sacc=(P0[0]+P0[1]); \
    GAPA(C0=__builtin_amdgcn_mfma_f32_32x32x16_bf16(kf[0],qr[0],negm,0,0,0), P0[2],P0[3],P0[4],P0[5],     pw0[0]=PKW(P0,0), pw0[1]=PKW(P0,2), pw0); \
    VRD(4); SBAR(); GAPA(C1=__builtin_amdgcn_mfma_f32_32x32x16_bf16(kf[1],qr[0],negm,0,0,0), P0[6],P0[7],P0[8],P0[9],     pw0[2]=PKW(P0,4), pw0[3]=PKW(P0,6), pw0); \
    VRD(1); SBAR(); GAPA(C0=__builtin_amdgcn_mfma_f32_32x32x16_bf16(kf[2],qr[1],C0,0,0,0),   P0[10],P0[11],P0[12],P0[13], pw1[0]=PKW(P0,8), pw1[1]=PKW(P0,10), pw1); \
    VRD(5); SBAR(); GAPA(C1=__builtin_amdgcn_mfma_f32_32x32x16_bf16(kf[3],qr[1],C1,0,0,0),   P0[14],P0[15],P1[0],P1[1],   pw1[2]=PKW(P0,12),pw1[3]=PKW(P0,14), pw1); \
    VRD(2); SBAR(); GAPA(C0=__builtin_amdgcn_mfma_f32_32x32x16_bf16(kf[4],qr[2],C0,0,0,0),   P1[2],P1[3],P1[4],P1[5],     pw2[0]=PKW(P1,0), pw2[1]=PKW(P1,2), pw2); \
    VRD(6); SBAR(); GAPA(C1=__builtin_amdgcn_mfma_f32_32x32x16_bf16(kf[5],qr[2],C1,0,0,0),   P1[6],P1[7],P1[8],P1[9],     pw2[2]=PKW(P1,4), pw2[3]=PKW(P1,6), pw2); \
    VRD(3); SBAR(); GAPA(C0=__builtin_amdgcn_mfma_f32_32x32x16_bf16(kf[6],qr[3],C0,0,0,0),   P1[10],P1[11],P1[12],P1[13], pw3[0]=PKW(P1,8), pw3[1]=PKW(P1,10), pw3); \
    VRD(7); SBAR(); GAPA(C1=__builtin_amdgcn_mfma_f32_32x32x16_bf16(kf[7],qr[3],C1,0,0,0),   P1[14],P1[15],0.f,0.f,       pw3[2]=PKW(P1,12),pw3[3]=PKW(P1,14), pw3); \
    l_reg+=sacc; \
    if(GK){DMA_K((t)+3,sl_cur);} if(GV){DMA_V((t)+1,sl_next);} \
    CMASK(C0,C1,t); \
    { float a=MX3(C0[0],C0[1],C1[0]),b=MX3(C0[2],C0[3],C1[1]); a=MX3(a,C1[2],C1[3]); \
      _Pragma("unroll") for(int r=4;r<16;r+=4){a=MX3(a,C0[r],C0[r+1]);b=MX3(b,C0[r+2],C0[r+3]);a=MX3(a,C1[r],C1[r+1]);b=MX3(b,C1[r+2],C1[r+3]);} \
      float rm=__builtin_fmaxf(a,b); { auto rr=__builtin_amdgcn_permlane32_swap(__float_as_uint(rm),__float_as_uint(rm),false,false); rm=__builtin_fmaxf(__uint_as_float(rr[0]),__uint_as_float(rr[1])); } \
      resc=false; \
      if(__builtin_expect(__any(rm>(float)THRL),0)){ const float dl=__builtin_fmaxf(rm,0.f); mhat+=dl; \
        _Pragma("unroll") for(int r=0;r<16;++r){C0[r]-=dl;C1[r]-=dl;} \
        _Pragma("unroll") for(int r=0;r<16;++r)negm[r]=-mhat; asm volatile("":"+v"(negm)); \
        const float f=__builtin_amdgcn_exp2f(-dl); l_reg*=f; if(hi==0)wsf[r32]=f; resc=true; } } \
    SBAR(); \
    GAPB(o[0]=__builtin_amdgcn_mfma_f32_32x32x16_bf16(PAF(0),VFR(0),o[0],0,0,0), C0,0); \
    GAPB(o[1]=__builtin_amdgcn_mfma_f32_32x32x16_bf16(PAF(0),VFR(4),o[1],0,0,0), C0,4); \
    KRD(GL,0); GAPB(o[0]=__builtin_amdgcn_mfma_f32_32x32x16_bf16(PAF(1),VFR(1),o[0],0,0,0), C0,8); \
    KRD(GL,1); GAPB(o[1]=__builtin_amdgcn_mfma_f32_32x32x16_bf16(PAF(1),VFR(5),o[1],0,0,0), C0,12); \
    KRD(GL,2); GAPB(o[0]=__builtin_amdgcn_mfma_f32_32x32x16_bf16(PAF(2),VFR(2),o[0],0,0,0), C1,0); \
    KRD(GL,3); GAPB(o[1]=__builtin_amdgcn_mfma_f32_32x32x16_bf16(PAF(2),VFR(6),o[1],0,0,0), C1,4); \
    GAPB(o[0]=__builtin_amdgcn_mfma_f32_32x32x16_bf16(PAF(3),VFR(3),o[0],0,0,0), C1,8); \
    GAPB(o[1]=__builtin_amdgcn_mfma_f32_32x32x16_bf16(PAF(3),VFR(7),o[1],0,0,0), C1,12); \
    }while(0)
  int t=1;
  #undef CMASK
  #define CMASK(P0,P1,t) do{}while(0)
  for(;t+5<NT;t+=2){
    STEP(pB0,pB1,pA0,pA1,t,true,true,true);     WAIT_BAR(2); RESC(); ROT();
    STEP(pA0,pA1,pB0,pB1,t+1,true,true,true);   WAIT_BAR(2); RESC(); ROT();
  }
  #undef CMASK
  #define CMASK(P0,P1,t) do{int jb_=(t)-(NT-4); if(jb_>=0)cmask(P0,P1,jb_,qrel,hi);}while(0)
  #define ENDW(tt) do{ if((tt)+3<NT){WAIT_BAR(2);} else if((tt)+2<NT){WAIT_BAR(1);} else {WAIT_BAR(0);} }while(0)
  for(;t+1<NT;t+=2){
    STEP(pB0,pB1,pA0,pA1,t,(t+3<NT),(t+1<NT),(t+1<NT));       ENDW(t);   RESC(); ROT();
    STEP(pA0,pA1,pB0,pB1,t+1,(t+4<NT),(t+2<NT),(t+2<NT));     ENDW(t+1); RESC(); ROT();
  }
  STEP(pB0,pB1,pA0,pA1,NT-1,false,false,false); RESC();
  { float sacc=pB0[0]+pB0[1]; _Pragma("unroll") for(int r=2;r<16;++r)sacc+=pB0[r]; _Pragma("unroll") for(int r=0;r<16;++r)sacc+=pB1[r]; l_reg+=sacc;
    pw0=(u32x4){PKW(pB0,0),PKW(pB0,2),PKW(pB0,4),PKW(pB0,6)};pw1=(u32x4){PKW(pB0,8),PKW(pB0,10),PKW(pB0,12),PKW(pB0,14)};pw2=(u32x4){PKW(pB1,0),PKW(pB1,2),PKW(pB1,4),PKW(pB1,6)};pw3=(u32x4){PKW(pB1,8),PKW(pB1,10),PKW(pB1,12),PKW(pB1,14)};
    SBAR(); pv(o,vb0+sl_cur,PAF(0),PAF(1),PAF(2),PAF(3)); }
  { qkt(pA0,pA1,shm+LDS_HK,qr,negm,r32,hi);asm volatile("s_nop 15\n\ts_nop 7":"+v"(pA0),"+v"(pA1));hmask(pA0,pA1);
    const float rm=rowmax(pA0,pA1); const float dl=__builtin_fmaxf(rm,0.f);
    _Pragma("unroll") for(int r=0;r<16;++r){pA0[r]=__builtin_amdgcn_exp2f(pA0[r]-dl);pA1[r]=__builtin_amdgcn_exp2f(pA1[r]-dl);}
    const float f=__builtin_amdgcn_exp2f(-dl); l_reg*=f; if(hi==0)wsf[r32]=f; asm volatile("s_waitcnt lgkmcnt(0)":::"memory");
    _Pragma("unroll") for(int d_=0;d_<2;++d_) _Pragma("unroll") for(int r=0;r<16;++r)o[d_][r]*=wsf[crow(r,hi)];
    float sacc=pA0[0]+pA0[1]; _Pragma("unroll") for(int r=2;r<16;++r)sacc+=pA0[r]; _Pragma("unroll") for(int r=0;r<16;++r)sacc+=pA1[r]; l_reg+=sacc;
    pw0=(u32x4){PKW(pA0,0),PKW(pA0,2),PKW(pA0,4),PKW(pA0,6)};pw1=(u32x4){PKW(pA0,8),PKW(pA0,10),PKW(pA0,12),PKW(pA0,14)};pw2=(u32x4){PKW(pA1,0),PKW(pA1,2),PKW(pA1,4),PKW(pA1,6)};pw3=(u32x4){PKW(pA1,8),PKW(pA1,10),PKW(pA1,12),PKW(pA1,14)};
    SBAR(); pv(o,vb0+(LDS_HV-LDS_V),PAF(0),PAF(1),PAF(2),PAF(3)); }
  #undef PKW
  #undef PAF
  #undef VFR
  #undef PIN
  #undef MX3
  #undef GAPA
  #undef GAPB
  #undef EX
  #undef VRD
  #undef KRD
  #undef STEP
  #undef ENDW
  {auto rr=__builtin_amdgcn_permlane32_swap(__float_as_uint(l_reg),__float_as_uint(l_reg),false,false);l_reg=__uint_as_float(rr[0])+__uint_as_float(rr[1]);}
  if(hi==0)wsf[32+r32]=l_reg;asm volatile("s_waitcnt lgkmcnt(0)":::"memory");
  float rli[16];
  #pragma unroll
  for(int r=0;r<16;++r)rli[r]=__builtin_amdgcn_rcpf(wsf[32+crow(r,hi)]);
  bf16*Ow=Ou+(long)(q0+wid*QBLK)*DM;
  { bf16*stg=(bf16*)(shm+LDS_OST)+wid*2048;
    #pragma unroll
    for(int r=0;r<16;++r){const int orow=crow(r,hi);
      #pragma unroll
      for(int d0=0;d0<2;++d0)stg[orow*64+d0*32+r32]=__float2bfloat16(o[d0][r]*rli[r]);}
    asm volatile("s_waitcnt lgkmcnt(0)":::"memory");
    #pragma unroll
    for(int i=0;i<4;++i){const int row=i*8+(lane>>3),ch=lane&7; const u32x4 v=*(const u32x4*)(stg+row*64+ch*8); ATTN_STORE16(Ow+(long)row*DM+ch*8,v);} }
  asm volatile("s_waitcnt lgkmcnt(0)\n\ts_barrier":::"memory");
  #undef DMA_K
  #undef DMA_V
  #undef CMASK
  #undef START
  #undef RESC
  #undef ROT
}
constexpr int ATTN_LDS_BYTES=LDS_BYTES;
struct AttnTensors { const bf16* Q; const bf16* K; const bf16* V; const bf16* KH; const bf16* VH; bf16* O1; bf16* O2; };
struct AttnUnit { int bh; int qb; };
struct StaticOrder {
  int vcu;
  __device__ __forceinline__ explicit StaticOrder(int grid,int block):vcu((block%8)*(grid/8)+block/8){}
  __device__ __forceinline__ bool next(int i,AttnUnit&u)const{ if(i>=4)return false; const int s=vcu&7; u.bh=vcu>>3; u.qb=(i==0)?s:(i==1)?15-s:(i==2)?16+s:31-s; return true; }
  __device__ __forceinline__ void a_ready(const AttnUnit&)const{}
  __device__ __forceinline__ void done(const AttnUnit&)const{}
};
template<class Sched,int THRL=8> __device__ __forceinline__ void attn_phase(char*lds,const AttnTensors&T,const Sched&S){
  AttnUnit u;
  for(int i=0;S.next(i,u);++i){ S.a_ready(u); const int vh=u.bh&1,c=(u.bh>>1)&1,h=(u.bh>>2)&3,b=u.bh>>4;
    attn_unit<THRL>(u.qb,T.Q+(long)b*SEQ*DM+h*128+c*64,T.K+(long)b*SEQ*DM+h*128+c*64,T.V+(long)b*SEQ*DM+h*128+vh*64,T.KH+(long)b*64*DM+h*128+c*64,T.VH+(long)b*64*DM+h*128+vh*64,(c?T.O2:T.O1)+(long)b*SEQ*DM+h*128+vh*64,lds); S.done(u); }
}
#undef SBAR
#undef WAIT_BAR
}
#define GAS __attribute__((address_space(1)))
#define LAS __attribute__((address_space(3)))
typedef unsigned short bf16;
typedef unsigned v4u __attribute__((ext_vector_type(4)));
typedef float f32x4 __attribute__((ext_vector_type(4)));
typedef short bf16x8 __attribute__((ext_vector_type(8)));
typedef GAS unsigned gu32;
typedef GAS unsigned long long gu64;
#define RLX_AGENT __ATOMIC_RELAXED, __HIP_MEMORY_SCOPE_AGENT
#define LDS_WAIT() asm volatile("s_waitcnt lgkmcnt(0)" ::: "memory")
#define VM_WAIT() asm volatile("s_waitcnt vmcnt(0)" ::: "memory")
__device__ __forceinline__ unsigned long long rt() { return __builtin_amdgcn_s_memrealtime(); }
__device__ __forceinline__ unsigned f2bf(float f) { unsigned u = __builtin_bit_cast(unsigned, f); return (u + 0x7fffu + ((u >> 16) & 1u)) >> 16; }
__device__ __forceinline__ unsigned pk2(float lo, float hi) { return f2bf(lo) | (f2bf(hi) << 16); }

#define XB_TMO      128
#define XB_XCNT(j)  (256  + 64 * (j))
#define XB_XSUB(j)  (1280 + 64 * (j))
#define XB_XGEN(j)  (2304 + 64 * (j))
#define XB_TOP      3328
#define XB_TOPGEN   3392
#define XCD_BAR_WORDS 3456
#define XB_SPIN_CAP (1u << 18)

__device__ __forceinline__ unsigned xb_ld(unsigned* p)              { return __hip_atomic_load(p, __ATOMIC_RELAXED, __HIP_MEMORY_SCOPE_AGENT); }
__device__ __forceinline__ unsigned xb_add(unsigned* p, unsigned v) { return __hip_atomic_fetch_add(p, v, __ATOMIC_RELAXED, __HIP_MEMORY_SCOPE_AGENT); }
__device__ __forceinline__ unsigned xb_xcc_id() { return (unsigned)__builtin_amdgcn_s_getreg((3 << 11) | 20) & 0xFu; }
#define XB_SPIN(cond, bar) do { unsigned _sp = 0; while (cond) { __builtin_amdgcn_s_sleep(1); \
    if ((++_sp & 255u) == 0u) { if (xb_ld(&(bar)[XB_TMO])) break; if (_sp > XB_SPIN_CAP) { atomicAdd(&(bar)[XB_TMO], 1u); break; } } } } while (0)

struct XcdBarrier {
    unsigned* bar; unsigned x;
    volatile LAS unsigned* st;
};

__device__ __forceinline__ XcdBarrier xcd_barrier_post(unsigned* bar, volatile LAS unsigned* st) {
    XcdBarrier b; b.bar = bar; b.x = xb_xcc_id(); b.st = st;
    if (threadIdx.x == 0) (void)xb_add(&bar[XB_XCNT(b.x)], 1u);
    return b;
}
__device__ __forceinline__ void xcd_barrier_complete(unsigned* bar, unsigned x, unsigned& nloc, unsigned& nx) {
    const unsigned G = gridDim.x * gridDim.y * gridDim.z;
    unsigned sum, cnt, mine, sp = 0u;
    for (;;) {
        sum = 0u; cnt = 0u; mine = 0u;
#pragma unroll
        for (unsigned j = 0; j < 16; ++j) { const unsigned c = xb_ld(&bar[XB_XCNT(j)]); sum += c; cnt += (c > 0u) ? 1u : 0u; mine = (j == x) ? c : mine; }
        if (sum == G) break;
        __builtin_amdgcn_s_sleep(1);
        if ((++sp & 255u) == 0u) { if (xb_ld(&bar[XB_TMO])) break; if (sp > XB_SPIN_CAP) { atomicAdd(&bar[XB_TMO], 1u); break; } }
    }
    nloc = mine > 0u ? mine : 1u; nx = cnt > 0u ? cnt : 1u;
}

__device__ __forceinline__ void xcd_barrier(const XcdBarrier& b) {
    asm volatile("s_waitcnt vmcnt(0)" ::: "memory");
    __syncthreads();
    if (threadIdx.x == 0) {
        unsigned* bar = b.bar;
        __builtin_amdgcn_s_waitcnt(0);
        unsigned nloc = b.st[0], nx = b.st[1];
        if (nloc == 0u) { xcd_barrier_complete(bar, b.x, nloc, nx); b.st[0] = nloc; b.st[1] = nx; }
        const unsigned old = xb_add(&bar[XB_XSUB(b.x)], 1u);
        const unsigned gen = old / nloc;
        if (old + 1u == (gen + 1u) * nloc) {
            __builtin_amdgcn_fence(__ATOMIC_RELEASE, "agent");
            asm volatile("s_waitcnt vmcnt(0)" ::: "memory");
            const unsigned og = xb_add(&bar[XB_TOP], 1u);
            const unsigned tg = og / nx;
            if (og + 1u == (tg + 1u) * nx) xb_add(&bar[XB_TOPGEN], 1u);
            else XB_SPIN(xb_ld(&bar[XB_TOPGEN]) == tg, bar);
            __builtin_amdgcn_fence(__ATOMIC_ACQUIRE, "agent");
            xb_add(&bar[XB_XGEN(b.x)], 1u);
            asm volatile("s_waitcnt vmcnt(0)" ::: "memory");
        } else {
            XB_SPIN(xb_ld(&bar[XB_XGEN(b.x)]) == gen, bar);
            __builtin_amdgcn_fence(__ATOMIC_ACQUIRE, "agent");
            asm volatile("s_waitcnt vmcnt(0)" ::: "memory");
        }
    }
    __syncthreads();
}
constexpr int DMODEL = 1024, SEQ = 8192, NBATCH = 2, NMETA = 16, DB = 32, DS = 8, DFF = 2816, NPAGES = 64, PAGE = 128;
constexpr int R_MAIN = NBATCH * SEQ;
constexpr int R_SMALL = 288;
constexpr int R_ALL = R_MAIN + R_SMALL;
constexpr int NIN = 3072;
constexpr float RMS_EPS = 1e-6f, SUBLN_EPS = 1e-5f, LAMBDA_INIT = 0.2f;
constexpr float QSCALE = 0.125f * 1.4426950408889634f;
constexpr size_t OUT_YP = 0, OUT_YS = 16777216, OUT_KP = 17039360, OUT_VP = 25444352, OUT_CP = 33849344, OUT_KS = 33851392, OUT_VS = 33982464, OUT_CS = 34113536, OUT_TOTAL = 34146304;

constexpr size_t MiB = 1u << 20;
constexpr size_t WS_CTL = 0, CTL_ZERO_BYTES = 1 * MiB;
constexpr size_t WS_W1GU = 2 * MiB;
constexpr size_t WS_W1D = 14 * MiB;
constexpr size_t WS_WIN = 20 * MiB;
constexpr size_t WS_WOUT = 26 * MiB;
constexpr size_t WS_W2GU = 28 * MiB;
constexpr size_t WS_W2D = 40 * MiB;
constexpr size_t WS_XN = 48 * MiB;
constexpr size_t WS_H = 82 * MiB;
constexpr size_t WS_Y = 172 * MiB;
constexpr size_t WS_X1 = 238 * MiB;
constexpr size_t WS_QB = 304 * MiB;
constexpr size_t WS_KB = 320 * MiB;
constexpr size_t WS_KH = 336 * MiB;
constexpr size_t WS_VH = WS_KH + 131072;
constexpr size_t WS_VB = 337 * MiB;
constexpr size_t WS_GB = 354 * MiB;
constexpr size_t WS_UB = 370 * MiB;
constexpr size_t WS_O1 = 386 * MiB;
constexpr size_t WS_O2 = 402 * MiB;
constexpr size_t WS_PS = 418 * MiB;
constexpr size_t WS_PO = 422 * MiB;
constexpr size_t WS_PML = 438 * MiB;
constexpr size_t WS_END = 440 * MiB;
constexpr int CW_BAR = 4096;

constexpr int RING_OFF = 0, RING_BYTES = 131072;
constexpr int LDSCTL_OFF = RING_BYTES, MISC_OFF = LDSCTL_OFF + 320;
constexpr int LDS_BYTES = 147456;
constexpr int NWAVES = 8;

typedef float f32x16 __attribute__((ext_vector_type(16)));
typedef unsigned u32x2 __attribute__((ext_vector_type(2)));

__device__ __forceinline__ float wave_sum(float v) {
#pragma unroll
    for (int o = 1; o < 64; o <<= 1) v += __shfl_xor(v, o);
    return v;
}
__device__ __forceinline__ unsigned pkbf(float lo, float hi) { return pg8::cvt_pk_bf16(lo, hi); }
__device__ __forceinline__ float bf2f(unsigned short h) { return __uint_as_float(((unsigned)h) << 16); }
__device__ __forceinline__ bf16x8 pack8(f32x4 a, f32x4 b) { v4u w; w.x = pkbf(a[0], a[1]); w.y = pkbf(a[2], a[3]); w.z = pkbf(b[0], b[1]); w.w = pkbf(b[2], b[3]); return __builtin_bit_cast(bf16x8, w); }

struct Args {
    const float* in[27]; const int* page_table; float* out; unsigned char* ws; int ph_lo, ph_hi; int li, pad;
};

template <int MODE> __device__ __forceinline__ int wrow_map(int n0) {
    if (MODE == 0) return n0;
    if (MODE == 1) return 256 * (n0 >> 7) + (n0 & 127);
    if (MODE == 2) return 256 * (n0 >> 7) + 128 + (n0 & 127);
    if (n0 < 2048) return n0;
    if (n0 < 2560) { const int j = n0 - 2048; return 2048 + 256 * (j >> 7) + (j & 127); }
    { const int j = n0 - 2560; return 2048 + 256 * (j >> 7) + 128 + (j & 127); }
}
template <int MODE> __device__ __forceinline__ void p0_transpose_item(const float* W, int K, int N, bf16* WT, LAS float* scr, int item, int lane) {
    const int nblk = N / 32, kb = item / nblk, nb = item % nblk, k0 = 64 * kb, n0 = 32 * nb;
    const int r0 = wrow_map<MODE>(n0);
#pragma unroll 8
    for (int i = 0; i < 32; ++i) { const int kk = 2 * i + (lane >> 5); scr[kk * 33 + (lane & 31)] = W[(size_t)(k0 + kk) * N + n0 + (lane & 31)]; }
    LDS_WAIT(); asm volatile("" ::: "memory");
    const int c = lane & 7;
#pragma unroll
    for (int j = 0; j < 4; ++j) { const int n = (lane >> 3) + 8 * j; const LAS float* s = scr + (8 * c) * 33 + n;
        v4u o; o.x = pkbf(s[0 * 33], s[1 * 33]); o.y = pkbf(s[2 * 33], s[3 * 33]); o.z = pkbf(s[4 * 33], s[5 * 33]); o.w = pkbf(s[6 * 33], s[7 * 33]);
        *(GAS v4u*)(WT + (size_t)(r0 + n) * K + k0 + 8 * c) = o; }
    LDS_WAIT(); asm volatile("" ::: "memory");
}

__device__ __forceinline__ void store_bf16_row4(bf16* orow, int lane, int j, f32x4 v) {
    u32x2 w; w.x = pkbf(v[0], v[1]); w.y = pkbf(v[2], v[3]); *(u32x2*)(orow + 4 * lane + 256 * j) = w;
}
__device__ __forceinline__ void norm_row(const float* xrow, const float* g, bf16* orow, int lane) {
    f32x4 v[4]; float ss = 0.f;
#pragma unroll
    for (int j = 0; j < 4; ++j) { v[j] = xrow ? ((const f32x4*)xrow)[lane + 64 * j] : (f32x4){0.f, 0.f, 0.f, 0.f}; ss += (v[j][0] * v[j][0] + v[j][1] * v[j][1]) + (v[j][2] * v[j][2] + v[j][3] * v[j][3]); }
    const float rstd = rsqrtf(wave_sum(ss) * (1.0f / DMODEL) + RMS_EPS);
#pragma unroll
    for (int j = 0; j < 4; ++j) { const f32x4 gj = ((const f32x4*)g)[lane + 64 * j]; store_bf16_row4(orow, lane, j, v[j] * rstd * gj); }
}
__device__ __forceinline__ void norm_res_row(const float* yrow, const float* xi, const float* gpost, float c, float* xo, const float* gnext, bf16* xn, int lane) {
    f32x4 y[4], x[4]; float ss = 0.f;
#pragma unroll
    for (int j = 0; j < 4; ++j) { y[j] = ((const f32x4*)yrow)[lane + 64 * j]; x[j] = xi ? ((const f32x4*)xi)[lane + 64 * j] : (f32x4){0.f, 0.f, 0.f, 0.f};
        ss += (y[j][0] * y[j][0] + y[j][1] * y[j][1]) + (y[j][2] * y[j][2] + y[j][3] * y[j][3]); }
    const float k = c * rsqrtf(wave_sum(ss) * (1.0f / DMODEL) + RMS_EPS);
    float s2 = 0.f;
#pragma unroll
    for (int j = 0; j < 4; ++j) { const f32x4 gj = ((const f32x4*)gpost)[lane + 64 * j]; x[j] = x[j] + y[j] * k * gj;
        s2 += (x[j][0] * x[j][0] + x[j][1] * x[j][1]) + (x[j][2] * x[j][2] + x[j][3] * x[j][3]);
        if (xo) ((f32x4*)xo)[lane + 64 * j] = x[j]; }
    if (xn) { const float rstd = rsqrtf(wave_sum(s2) * (1.0f / DMODEL) + RMS_EPS);
#pragma unroll
        for (int j = 0; j < 4; ++j) { const f32x4 gj = ((const f32x4*)gnext)[lane + 64 * j]; store_bf16_row4(xn, lane, j, x[j] * rstd * gj); } }
}

template <int NB> __device__ __forceinline__ void sgemm_tile(const bf16* A, const bf16* B0, const bf16* B1, int K, f32x16 (&acc)[NB], int lane) {
    const int r = lane & 31, hi = lane >> 5;
    const bf16* ap = A + (size_t)r * K + 8 * hi; const bf16* bp0 = B0 + (size_t)r * K + 8 * hi; const bf16* bp1 = (NB > 1 ? B1 : B0) + (size_t)r * K + 8 * hi;
#pragma unroll
    for (int nb = 0; nb < NB; ++nb) acc[nb] = f32x16{};
    bf16x8 a[4], b0[4], b1[4];
#pragma unroll
    for (int s = 0; s < 4; ++s) { a[s] = *(const bf16x8*)(ap + 16 * s); b0[s] = *(const bf16x8*)(bp0 + 16 * s); if (NB > 1) b1[s] = *(const bf16x8*)(bp1 + 16 * s); }
    for (int kb = 64; kb <= K; kb += 64) {
        bf16x8 an[4], bn0[4], bn1[4];
        const int kn = kb < K ? kb : 0;
#pragma unroll
        for (int s = 0; s < 4; ++s) { an[s] = *(const bf16x8*)(ap + kn + 16 * s); bn0[s] = *(const bf16x8*)(bp0 + kn + 16 * s); if (NB > 1) bn1[s] = *(const bf16x8*)(bp1 + kn + 16 * s); }
#pragma unroll
        for (int s = 0; s < 4; ++s) { acc[0] = __builtin_amdgcn_mfma_f32_32x32x16_bf16(a[s], b0[s], acc[0], 0, 0, 0); if (NB > 1) acc[NB - 1] = __builtin_amdgcn_mfma_f32_32x32x16_bf16(a[s], b1[s], acc[NB - 1], 0, 0, 0); }
#pragma unroll
        for (int s = 0; s < 4; ++s) { a[s] = an[s]; b0[s] = bn0[s]; if (NB > 1) b1[s] = bn1[s]; }
    }
}
__device__ __forceinline__ int crow16(int reg, int hi) { return (reg & 3) + 8 * (reg >> 2) + 4 * hi; }

__device__ __forceinline__ void sattn_item(int item, const float* PS, const float* ck, const float* cv, const int* pt, float* part_o, float* part_ml, int lane) {
    const int db = item >> 6, h = (item >> 4) & 3, ch = item & 15, g = lane >> 4, r = lane & 15;
    bf16x8 qf[4];
    { const int c = r >> 3, t = r & 7; const float* qrow = PS + (size_t)(NMETA + db * DS + t) * NIN + h * 128;
#pragma unroll
      for (int s = 0; s < 4; ++s) { const int cs = s >> 1; const float* qp = qrow + cs * 64 + 32 * (s & 1) + 4 * g;
          f32x4 lo = *(const f32x4*)qp, hi = *(const f32x4*)(qp + 16); if (c != cs) { lo = (f32x4){0.f, 0.f, 0.f, 0.f}; hi = lo; }
          qf[s] = pack8(lo * QSCALE, hi * QSCALE); } }
    float m = -INFINITY, lsum = 0.f; f32x4 O[8];
#pragma unroll
    for (int e = 0; e < 8; ++e) O[e] = (f32x4){0.f, 0.f, 0.f, 0.f};
    const f32x4 z4 = (f32x4){0.f, 0.f, 0.f, 0.f};
    for (int pi = 0; pi < 4; ++pi) {
        const int page = pt[db * NPAGES + ch * 4 + pi];
        const float* kp = ck + (size_t)page * (PAGE * 512) + h * 128 + (size_t)r * 512 + 4 * g;
        const float* vp = cv + (size_t)page * (PAGE * 512) + h * 128 + (size_t)(4 * g) * 512 + 4 * r;
#pragma unroll 1
        for (int sb = 0; sb < 8; ++sb) {
            f32x4 kl[8], vl[4][2];
#pragma unroll
            for (int i = 0; i < 8; ++i) kl[i] = __builtin_nontemporal_load((const f32x4*)(kp + 16 * i));
#pragma unroll
            for (int j = 0; j < 4; ++j)
#pragma unroll
                for (int hf = 0; hf < 2; ++hf) vl[j][hf] = __builtin_nontemporal_load((const f32x4*)(vp + j * 512 + 64 * hf));
            kp += 16 * 512; vp += 16 * 512;
            f32x4 S = z4;
#pragma unroll
            for (int s = 0; s < 4; ++s) S = __builtin_amdgcn_mfma_f32_16x16x32_bf16(pack8(kl[2 * s], kl[2 * s + 1]), qf[s], S, 0, 0, 0);
            float mx = fmaxf(fmaxf(S[0], S[1]), fmaxf(S[2], S[3]));
            mx = fmaxf(mx, __shfl_xor(mx, 16)); mx = fmaxf(mx, __shfl_xor(mx, 32));
            const float mn = fmaxf(m, mx), sc = __builtin_amdgcn_exp2f(m - mn); m = mn;
            f32x4 P;
#pragma unroll
            for (int i = 0; i < 4; ++i) P[i] = __builtin_amdgcn_exp2f(S[i] - mn);
            lsum = lsum * sc + ((P[0] + P[1]) + (P[2] + P[3]));
#pragma unroll
            for (int reg = 0; reg < 4; ++reg) { const float f = __shfl(sc, 4 * g + reg);
#pragma unroll
                for (int e = 0; e < 8; ++e) O[e][reg] *= f; }
            const bf16x8 pa = pack8(P, z4);
#pragma unroll
            for (int e = 0; e < 8; ++e) {
                f32x4 lo;
#pragma unroll
                for (int j = 0; j < 4; ++j) lo[j] = vl[j][e >> 2][e & 3];
                O[e] = __builtin_amdgcn_mfma_f32_16x16x32_bf16(pa, pack8(lo, z4), O[e], 0, 0, 0);
            }
        }
    }
    lsum += __shfl_xor(lsum, 16); lsum += __shfl_xor(lsum, 32);
    if (g == 0) { part_ml[(size_t)item * 32 + r] = m; part_ml[(size_t)item * 32 + 16 + r] = lsum; }
#pragma unroll
    for (int reg = 0; reg < 4; ++reg)
#pragma unroll
        for (int hf = 0; hf < 2; ++hf) { f32x4 o; o[0] = O[4 * hf + 0][reg]; o[1] = O[4 * hf + 1][reg]; o[2] = O[4 * hf + 2][reg]; o[3] = O[4 * hf + 3][reg];
            *(f32x4*)(part_o + ((size_t)item * 16 + 4 * g + reg) * 128 + 64 * hf + 4 * r) = o; }
}
__device__ __forceinline__ void unpack8(v4u w, float (&f)[8]) {
#pragma unroll
    for (int i = 0; i < 4; ++i) { const unsigned x = w[i]; f[2 * i] = __uint_as_float(x << 16); f[2 * i + 1] = __uint_as_float(x & 0xffff0000u); }
}
__device__ __forceinline__ v4u pack8f(const float (&f)[8]) { v4u w; w.x = pkbf(f[0], f[1]); w.y = pkbf(f[2], f[3]); w.z = pkbf(f[4], f[5]); w.w = pkbf(f[6], f[7]); return w; }
__device__ __forceinline__ void load8f(const float* p, float (&f)[8]) { const f32x4 a = *(const f32x4*)p, b = *(const f32x4*)(p + 4); f[0] = a[0]; f[1] = a[1]; f[2] = a[2]; f[3] = a[3]; f[4] = b[0]; f[5] = b[1]; f[6] = b[2]; f[7] = b[3]; }
__device__ __forceinline__ void small_u8(const float* PS, int q, int j0, float (&u)[8]) {
    const int n = 2048 + 256 * (j0 >> 7) + (j0 & 127); float a[8], b[8]; load8f(PS + (size_t)q * NIN + n, a); load8f(PS + (size_t)q * NIN + n + 128, b);
#pragma unroll
    for (int i = 0; i < 8; ++i) u[i] = a[i] * b[i];
}
__device__ __forceinline__ void subln_store(float (&o)[8], const float* subln_g, bf16* dst, int lane) {
    float ss = 0.f;
#pragma unroll
    for (int i = 0; i < 8; ++i) ss += o[i] * o[i];
    ss += __shfl_xor(ss, 1); ss += __shfl_xor(ss, 2); ss += __shfl_xor(ss, 4); ss += __shfl_xor(ss, 8);
    const float rstd = rsqrtf(ss * (1.0f / 128.0f) + SUBLN_EPS) * (1.0f - LAMBDA_INIT);
    float g[8]; load8f(subln_g + 8 * (lane & 15), g);
#pragma unroll
    for (int i = 0; i < 8; ++i) o[i] = o[i] * rstd * g[i];
    *(v4u*)dst = pack8f(o);
}
__device__ __forceinline__ void conv_store(const float (&gb)[8], const float (&u0)[8], const float (&u1)[8], const float (&u2)[8], const float* conv_w, int j0, bf16* dst) {
    float w0[8], w1[8], w2[8], c[8]; load8f(conv_w + j0, w0); load8f(conv_w + 512 + j0, w1); load8f(conv_w + 1024 + j0, w2);
#pragma unroll
    for (int i = 0; i < 8; ++i) c[i] = gb[i] * (w0[i] * u2[i] + w1[i] * u1[i] + w2[i] * u0[i]);
    *(v4u*)dst = pack8f(c);
}
__device__ __forceinline__ void combine_main_row(int row, float lam, const bf16* O1, const bf16* O2, const bf16* GB, const bf16* UB, const float* PS, const float* subln_g, const float* conv_w, bf16* AO, int lane) {
    const int s = row & (SEQ - 1), j0 = 8 * lane;
    float a[8], b[8];
    unpack8(*(const v4u*)(O1 + (size_t)row * 512 + j0), a); unpack8(*(const v4u*)(O2 + (size_t)row * 512 + j0), b);
#pragma unroll
    for (int i = 0; i < 8; ++i) a[i] = a[i] - lam * b[i];
    subln_store(a, subln_g, AO + (size_t)row * DMODEL + j0, lane);
    float gb[8], u0[8], u1[8], u2[8];
    unpack8(*(const v4u*)(GB + (size_t)row * 512 + j0), gb); unpack8(*(const v4u*)(UB + (size_t)row * 512 + j0), u0);
    if (s >= 1) unpack8(*(const v4u*)(UB + (size_t)(row - 1) * 512 + j0), u1); else small_u8(PS, 15, j0, u1);
    if (s >= 2) unpack8(*(const v4u*)(UB + (size_t)(row - 2) * 512 + j0), u2); else small_u8(PS, 14 + s, j0, u2);
    conv_store(gb, u0, u1, u2, conv_w, j0, AO + (size_t)row * DMODEL + 512 + j0);
}
__device__ __forceinline__ void combine_sample_row(int db, int t, float lam, const float* PS, const float* part_o, const float* part_ml, const float* state_conv, const float* subln_g, const float* conv_w, bf16* AO, float* out_cs, int lane) {
    const int h = lane >> 4, sub = lane & 15, e0 = 8 * sub, q = NMETA + db * DS + t;
    float a[8];
#pragma unroll 1
    for (int c = 0; c < 2; ++c) {
        const int col = c * 8 + t;
        float M = -INFINITY;
#pragma unroll 1
        for (int ch = 0; ch < 16; ++ch) M = fmaxf(M, part_ml[(size_t)((db * 4 + h) * 16 + ch) * 32 + col]);
        const f32x4 q4 = *(const f32x4*)(PS + (size_t)q * NIN + h * 128 + c * 64 + 4 * sub);
        float sn[8];
#pragma unroll
        for (int tp = 0; tp < 8; ++tp) { const f32x4 k4 = *(const f32x4*)(PS + (size_t)(NMETA + db * DS + tp) * NIN + 512 + h * 128 + c * 64 + 4 * sub);
            float d = (q4[0] * k4[0] + q4[1] * k4[1]) + (q4[2] * k4[2] + q4[3] * k4[3]);
            d += __shfl_xor(d, 1); d += __shfl_xor(d, 2); d += __shfl_xor(d, 4); d += __shfl_xor(d, 8);
            sn[tp] = (tp <= t) ? d * QSCALE : -INFINITY; M = fmaxf(M, sn[tp]); }
        float L = 0.f, acc[8];
#pragma unroll
        for (int i = 0; i < 8; ++i) acc[i] = 0.f;
#pragma unroll 2
        for (int ch = 0; ch < 16; ++ch) { const size_t item = (size_t)((db * 4 + h) * 16 + ch);
            const float w = __builtin_amdgcn_exp2f(part_ml[item * 32 + col] - M); L += part_ml[item * 32 + 16 + col] * w;
            float o[8]; load8f(part_o + (item * 16 + col) * 128 + e0, o);
#pragma unroll
            for (int i = 0; i < 8; ++i) acc[i] += w * o[i]; }
#pragma unroll
        for (int tp = 0; tp < 8; ++tp) { const float p = __builtin_amdgcn_exp2f(sn[tp] - M); L += p;
            float v[8]; load8f(PS + (size_t)(NMETA + db * DS + tp) * NIN + 1024 + h * 128 + e0, v);
#pragma unroll
            for (int i = 0; i < 8; ++i) acc[i] += p * v[i]; }
        const float inv = 1.0f / L;
#pragma unroll
        for (int i = 0; i < 8; ++i) a[i] = (c == 0) ? acc[i] * inv : a[i] - lam * acc[i] * inv;
    }
    const int row = R_MAIN + q, j0 = 8 * lane;
    subln_store(a, subln_g, AO + (size_t)row * DMODEL + j0, lane);
    float gb[8], u0[8], u1[8], u2[8];
    load8f(PS + (size_t)q * NIN + 1536 + j0, gb); small_u8(PS, q, j0, u0);
    if (t >= 1) small_u8(PS, q - 1, j0, u1); else load8f(state_conv + (size_t)(db * 2 + 1) * 512 + j0, u1);
    if (t >= 2) small_u8(PS, q - 2, j0, u2); else load8f(state_conv + (size_t)(db * 2 + t) * 512 + j0, u2);
    conv_store(gb, u0, u1, u2, conv_w, j0, AO + (size_t)row * DMODEL + 512 + j0);
    if (t >= 6) { float* o = out_cs + (size_t)(db * 2 + (t - 6)) * 512 + j0; *(f32x4*)o = (f32x4){u0[0], u0[1], u0[2], u0[3]}; *(f32x4*)(o + 4) = (f32x4){u0[4], u0[5], u0[6], u0[7]}; }
}

#ifndef MK_N_LAUNCHES
#define MK_N_LAUNCHES 1
#endif
constexpr int N_PHASES = 12;
typedef const __attribute__((address_space(4))) Args* KArgs;
#define PHASE_BEGIN(k) KArgs A_ = (KArgs)__builtin_amdgcn_kernarg_segment_ptr(); asm volatile("; PHASE_MARK " #k : "+s"(A_)); unsigned char* const ws = A_->ws; (void)ws
#define FRESH_LANE() int lane = threadIdx.x & 63; asm volatile("" : "+v"(lane))
#define WSP(T, off) ((T*)(ws + (off)))
__device__ __forceinline__ const float* x0_row(KArgs a, int row) {
    if (row < R_MAIN) return a->in[0] + (size_t)row * DMODEL;
    const int q = row - R_MAIN;
    if (q < NMETA) return a->in[6] + (size_t)q * DMODEL;
    if (q < NMETA + DB * DS) return a->in[1] + (size_t)(q - NMETA) * DMODEL;
    return nullptr;
}
__global__ void __launch_bounds__(NWAVES * 64, 2) fwd_kernel(Args args) {
    extern __shared__ __attribute__((aligned(16))) unsigned char lds[];
    LAS unsigned char* ldsl = (LAS unsigned char*)lds;
    volatile LAS unsigned* MISC = (volatile LAS unsigned*)(ldsl + MISC_OFF);
    const int wave = __builtin_amdgcn_readfirstlane(threadIdx.x >> 6);
    const int G = gridDim.x, bx = blockIdx.x, vcu = (G % 8 == 0) ? (bx % 8) * (G / 8) + bx / 8 : bx;
    for (int u = threadIdx.x; u < (LDS_BYTES - LDSCTL_OFF) / 4; u += NWAVES * 64) ((LAS unsigned*)(ldsl + LDSCTL_OFF))[u] = 0u;
    __syncthreads();
    XcdBarrier bar; bar.bar = (unsigned*)(args.ws + WS_CTL) + CW_BAR; bar.x = 0; bar.st = nullptr;
    if (MK_N_LAUNCHES == 1) bar = xcd_barrier_post((unsigned*)(args.ws + WS_CTL) + CW_BAR, MISC + 8);
#define GRID_BAR() do { if (MK_N_LAUNCHES == 1) xcd_barrier(bar); } while (0)
#ifdef MK_FIXED_LO
    const int lo = MK_FIXED_LO, hi = MK_FIXED_HI;
#else
    const int lo = args.ph_lo, hi = args.ph_hi;
#endif
#define IN(k) (lo <= (k) && (k) < hi)
#define BOTH(k) (IN(k) && IN((k) + 1))
    const int gw = vcu * NWAVES + wave, NGW = G * NWAVES;
    const int sw = (G - 1 - bx) * NWAVES + wave;

    if (IN(0)) { PHASE_BEGIN(0); FRESH_LANE();
        LAS float* scr = (LAS float*)(ldsl + RING_OFF + wave * 16384);
        constexpr int I_GU = 16 * 88, I_D = 44 * 32, I_IN = 16 * 96, I_O = 16 * 32;
        constexpr int NITEMS = 2 * (2 * I_GU + I_D) + I_IN + I_O;
        for (int it = gw; it < NITEMS; it += NGW) {
            int r = it;
            if (r < I_GU) { p0_transpose_item<1>(A_->in[8], DMODEL, DFF, WSP(bf16, WS_W1GU), scr, r, lane); continue; } r -= I_GU;
            if (r < I_GU) { p0_transpose_item<2>(A_->in[9], DMODEL, DFF, WSP(bf16, WS_W1GU), scr, r, lane); continue; } r -= I_GU;
            if (r < I_D) { p0_transpose_item<0>(A_->in[10], DFF, DMODEL, WSP(bf16, WS_W1D), scr, r, lane); continue; } r -= I_D;
            if (r < I_IN) { p0_transpose_item<3>(A_->in[13], DMODEL, NIN, WSP(bf16, WS_WIN), scr, r, lane); continue; } r -= I_IN;
            if (r < I_O) { p0_transpose_item<0>(A_->in[20], DMODEL, DMODEL, WSP(bf16, WS_WOUT), scr, r, lane); continue; } r -= I_O;
            if (r < I_GU) { p0_transpose_item<1>(A_->in[23], DMODEL, DFF, WSP(bf16, WS_W2GU), scr, r, lane); continue; } r -= I_GU;
            if (r < I_GU) { p0_transpose_item<2>(A_->in[24], DMODEL, DFF, WSP(bf16, WS_W2GU), scr, r, lane); continue; } r -= I_GU;
            p0_transpose_item<0>(A_->in[25], DFF, DMODEL, WSP(bf16, WS_W2D), scr, r, lane);
        }
        for (int row = gw; row < R_ALL; row += NGW) norm_row(x0_row(A_, row), A_->in[7], WSP(bf16, WS_XN) + (size_t)row * DMODEL, lane);
        for (int i = gw; i < 192; i += NGW) { const int buf = i / 96, b = (i % 96) / 48, rr = 16 + (i % 48);
            bf16* p = WSP(bf16, buf ? WS_VH : WS_KH) + (size_t)(b * 64 + rr) * 512 + 8 * lane; *(v4u*)p = (v4u){0u, 0u, 0u, 0u}; }
        if (BOTH(0)) GRID_BAR();
    }
#define FFN_UP(k, WOFF) do { PHASE_BEGIN(k); bf16* const XN = WSP(bf16, WS_XN); bf16* const WGU = WSP(bf16, WOFF); bf16* const HB = WSP(bf16, WS_H); \
        { pg8::Gemm g{XN, WGU, R_MAIN, 2 * DFF, DMODEL}; pg8::StaticOrder S; S.init(R_MAIN, 2 * DFF, G, bx); \
          pg8::EpiSwiGLU E{HB, DFF}; \
          pg8::gemm_phase<pg8::EpiSwiGLU, pg8::StaticOrder, true, true>(ldsl + RING_OFF, g, S, E); } \
        FRESH_LANE(); \
        for (int tile = sw; tile < 9 * 88; tile += NGW) { const int rb = tile % 9, cb = tile / 9, grow = 256 * (cb >> 2) + 32 * (cb & 3); \
            f32x16 acc[2]; sgemm_tile<2>(XN + (size_t)(R_MAIN + 32 * rb) * DMODEL, WGU + (size_t)grow * DMODEL, WGU + (size_t)(grow + 128) * DMODEL, DMODEL, acc, lane); \
            _Pragma("unroll") for (int reg = 0; reg < 16; ++reg) { const int row = R_MAIN + 32 * rb + crow16(reg, lane >> 5); \
                HB[(size_t)row * DFF + 32 * cb + (lane & 31)] = (bf16)(pkbf(pg8::silu_f(acc[0][reg]) * acc[1][reg], 0.f) & 0xffffu); } } \
    } while (0)
    if (IN(1)) { FFN_UP(1, WS_W1GU); if (BOTH(1)) GRID_BAR(); }
#define FFN_DOWN(k, WOFF) do { PHASE_BEGIN(k); bf16* const HB = WSP(bf16, WS_H); bf16* const WD = WSP(bf16, WOFF); float* const Y = WSP(float, WS_Y); \
        { pg8::Gemm g{HB, WD, R_MAIN, DMODEL, DFF}; pg8::StaticOrder S; S.init(R_MAIN, DMODEL, G, bx); \
          pg8::EpiF32 E{Y, DMODEL}; \
          pg8::gemm_phase<pg8::EpiF32, pg8::StaticOrder, false, true>(ldsl + RING_OFF, g, S, E); } \
        FRESH_LANE(); \
        for (int tile = sw; tile < 9 * 32; tile += NGW) { const int rb = tile % 9, cb = tile / 9; \
            f32x16 acc[1]; sgemm_tile<1>(HB + (size_t)(R_MAIN + 32 * rb) * DFF, WD + (size_t)(32 * cb) * DFF, nullptr, DFF, acc, lane); \
            _Pragma("unroll") for (int reg = 0; reg < 16; ++reg) { const int row = R_MAIN + 32 * rb + crow16(reg, lane >> 5); Y[(size_t)row * DMODEL + 32 * cb + (lane & 31)] = acc[0][reg]; } } \
    } while (0)
    if (IN(2)) { FFN_DOWN(2, WS_W1D); if (BOTH(2)) GRID_BAR(); }
    if (IN(3)) { PHASE_BEGIN(3); FRESH_LANE();
        for (int row = gw; row < R_ALL; row += NGW) norm_res_row(WSP(float, WS_Y) + (size_t)row * DMODEL, x0_row(A_, row), A_->in[11], 0.5f, WSP(float, WS_X1) + (size_t)row * DMODEL, A_->in[12], WSP(bf16, WS_XN) + (size_t)row * DMODEL, lane);
        if (BOTH(3)) GRID_BAR();
    }
    if (IN(4)) { PHASE_BEGIN(4); bf16* const XN = WSP(bf16, WS_XN); bf16* const WIN = WSP(bf16, WS_WIN); bf16* const KB = WSP(bf16, WS_KB); bf16* const VB = WSP(bf16, WS_VB); bf16* const KH = WSP(bf16, WS_KH); bf16* const VH = WSP(bf16, WS_VH); float* const out = A_->out;
        { pg8::Gemm g{XN, WIN, R_MAIN, NIN, DMODEL}; pg8::StaticOrder S; S.init(R_MAIN, NIN, G, bx);
          pg8::EpiWin E{WSP(bf16, WS_QB), KB, VB, WSP(bf16, WS_GB), WSP(bf16, WS_UB), out + OUT_KP, out + OUT_VP, out + OUT_CP, QSCALE};
          pg8::gemm_phase<pg8::EpiWin, pg8::StaticOrder, true, true>(ldsl + RING_OFF, g, S, E); }
        FRESH_LANE(); float* const PS = WSP(float, WS_PS);
        for (int tile = sw; tile < 9 * 96; tile += NGW) { const int rb = tile % 9, cb = tile / 9, n0 = 32 * cb;
            f32x16 acc[1]; sgemm_tile<1>(XN + (size_t)(R_MAIN + 32 * rb) * DMODEL, WIN + (size_t)n0 * DMODEL, nullptr, DMODEL, acc, lane);
            const int n = n0 + (lane & 31);
#pragma unroll
            for (int reg = 0; reg < 16; ++reg) { const int i = 32 * rb + crow16(reg, lane >> 5); const float v = acc[0][reg];
                PS[(size_t)i * NIN + n] = v;
                if (n0 >= 512 && n0 < 1536) { const bool isk = n0 < 1024; const int cc = n - (isk ? 512 : 1024);
                    if (i < NMETA) { const bf16 hv = (bf16)(pkbf(v, 0.f) & 0xffffu);
#pragma unroll
                        for (int b = 0; b < NBATCH; ++b) { (isk ? KH : VH)[(size_t)(b * 64 + i) * 512 + cc] = hv; (out + (isk ? OUT_KP : OUT_VP))[(size_t)(b * (NMETA + SEQ) + i) * 512 + cc] = v; } }
                    else if (i < NMETA + DB * DS) (out + (isk ? OUT_KS : OUT_VS))[(size_t)(i - NMETA) * 512 + cc] = v; } } }
        if (BOTH(4)) GRID_BAR();
    }
    if (IN(5)) {
        { PHASE_BEGIN(5);
          const attn_body::AttnTensors AT{WSP(const attn_body::bf16, WS_QB), WSP(const attn_body::bf16, WS_KB), WSP(const attn_body::bf16, WS_VB), WSP(const attn_body::bf16, WS_KH), WSP(const attn_body::bf16, WS_VH), WSP(attn_body::bf16, WS_O1), WSP(attn_body::bf16, WS_O2)};
          const attn_body::StaticOrder S((int)G, (int)bx);
          attn_body::attn_phase<attn_body::StaticOrder>((char*)lds + RING_OFF, AT, S); }
        { PHASE_BEGIN(55); FRESH_LANE();
#ifndef NO_SATTN
          for (int item = gw; item < DB * 4 * 16; item += NGW) sattn_item(item, WSP(float, WS_PS), A_->in[2], A_->in[3], A_->page_table, WSP(float, WS_PO), WSP(float, WS_PML), lane);
#endif
        }
        if (BOTH(5)) GRID_BAR();
    }
    if (IN(6)) { PHASE_BEGIN(6); FRESH_LANE();
        const float l1 = wave_sum(A_->in[14][lane] * A_->in[15][lane]), l2 = wave_sum(A_->in[16][lane] * A_->in[17][lane]);
        const float lam = expf(l1) - expf(l2) + LAMBDA_INIT;
        for (int row = gw; row < R_MAIN; row += NGW) combine_main_row(row, lam, WSP(bf16, WS_O1), WSP(bf16, WS_O2), WSP(bf16, WS_GB), WSP(bf16, WS_UB), WSP(float, WS_PS), A_->in[18], A_->in[19], WSP(bf16, WS_XN), lane);
        for (int q = NGW - 1 - gw; q < DB * DS; q += NGW) combine_sample_row(q >> 3, q & 7, lam, WSP(float, WS_PS), WSP(float, WS_PO), WSP(float, WS_PML), A_->in[4], A_->in[18], A_->in[19], WSP(bf16, WS_XN), A_->out + OUT_CS, lane);
        if (BOTH(6)) GRID_BAR();
    }
    if (IN(7)) { PHASE_BEGIN(7); bf16* const XN = WSP(bf16, WS_XN); bf16* const WOUT = WSP(bf16, WS_WOUT); float* const Y = WSP(float, WS_Y);
        { pg8::Gemm g{XN, WOUT, R_MAIN, DMODEL, DMODEL}; pg8::StaticOrder S; S.init(R_MAIN, DMODEL, G, bx);
          pg8::EpiF32 E{Y, DMODEL};
          pg8::gemm_phase<pg8::EpiF32, pg8::StaticOrder, false, true>(ldsl + RING_OFF, g, S, E); }
        FRESH_LANE();
        for (int tile = sw; tile < 9 * 32; tile += NGW) { const int rb = tile % 9, cb = tile / 9;
            f32x16 acc[1]; sgemm_tile<1>(XN + (size_t)(R_MAIN + 32 * rb) * DMODEL, WOUT + (size_t)(32 * cb) * DMODEL, nullptr, DMODEL, acc, lane);
#pragma unroll
            for (int reg = 0; reg < 16; ++reg) { const int row = R_MAIN + 32 * rb + crow16(reg, lane >> 5); Y[(size_t)row * DMODEL + 32 * cb + (lane & 31)] = acc[0][reg]; } }
        if (BOTH(7)) GRID_BAR();
    }
    if (IN(8)) { PHASE_BEGIN(8); FRESH_LANE();
        for (int row = gw; row < R_ALL; row += NGW) norm_res_row(WSP(float, WS_Y) + (size_t)row * DMODEL, WSP(float, WS_X1) + (size_t)row * DMODEL, A_->in[21], 1.0f, WSP(float, WS_X1) + (size_t)row * DMODEL, A_->in[22], WSP(bf16, WS_XN) + (size_t)row * DMODEL, lane);
        if (BOTH(8)) GRID_BAR();
    }
    if (IN(9)) { FFN_UP(9, WS_W2GU); if (BOTH(9)) GRID_BAR(); }
    if (IN(10)) { FFN_DOWN(10, WS_W2D); if (BOTH(10)) GRID_BAR(); }
    if (IN(11)) { PHASE_BEGIN(11); FRESH_LANE(); float* const out = A_->out;
        for (int row = gw; row < R_MAIN + NMETA + DB * DS; row += NGW) {
            float* o = row < R_MAIN ? out + OUT_YP + (size_t)row * DMODEL : (row >= R_MAIN + NMETA ? out + OUT_YS + (size_t)(row - R_MAIN - NMETA) * DMODEL : nullptr);
            if (o) norm_res_row(WSP(float, WS_Y) + (size_t)row * DMODEL, WSP(float, WS_X1) + (size_t)row * DMODEL, A_->in[26], 0.5f, o, nullptr, nullptr, lane);
        }
    }
#undef IN
#undef BOTH
}

extern "C" void kernel_launch(void* const* d_in, const int* in_sizes, int n_in, void* d_out, int out_size, void* d_ws, size_t ws_size, hipStream_t stream) {
    static int grid = 0;
    if (grid == 0) {
        if (n_in != 27 || (size_t)out_size != OUT_TOTAL || ws_size < WS_END) { fprintf(stderr, "kernel_launch: unexpected shapes (n_in %d out %d ws %zu)\n", n_in, out_size, ws_size); grid = -1; return; }
        int dev = 0, cus = 0, per_cu = 0;
        if (hipGetDevice(&dev) != hipSuccess || hipDeviceGetAttribute(&cus, hipDeviceAttributeMultiprocessorCount, dev) != hipSuccess) { grid = -1; return; }
        if (hipFuncSetAttribute((const void*)fwd_kernel, hipFuncAttributeMaxDynamicSharedMemorySize, LDS_BYTES) != hipSuccess) { fprintf(stderr, "kernel_launch: hipFuncSetAttribute failed\n"); grid = -1; return; }
        if (hipOccupancyMaxActiveBlocksPerMultiprocessor(&per_cu, (const void*)fwd_kernel, NWAVES * 64, LDS_BYTES) != hipSuccess || per_cu < 1) fprintf(stderr, "kernel_launch: occupancy query says %d\n", per_cu);
        (void)hipGetLastError();
        grid = cus;
    }
    if (grid < 0) return;
    (void)hipMemsetAsync((char*)d_ws + WS_CTL, 0, CTL_ZERO_BYTES, stream);
    Args a{};
    for (int i = 0; i < 27; ++i) a.in[i] = (const float*)d_in[i];
    a.page_table = (const int*)d_in[5]; a.out = (float*)d_out; a.ws = (unsigned char*)d_ws;
    for (int li = 0; li < MK_N_LAUNCHES; ++li) {
        a.ph_lo = (MK_N_LAUNCHES == 1) ? 0 : li; a.ph_hi = (MK_N_LAUNCHES == 1) ? N_PHASES : li + 1; a.li = li; a.pad = 0;
        hipLaunchKernelGGL(fwd_kernel, dim3(grid), dim3(NWAVES * 64), LDS_BYTES, stream, a);
    }
}
```

```cpp
#include <hip/hip_runtime.h>
#include <cstdio>
#include <cstdint>
namespace pg8 {
#define PG8_LAS __attribute__((address_space(3)))
typedef unsigned short bf16_t;
typedef short bf16x8 __attribute__((ext_vector_type(8)));
typedef float f32x4 __attribute__((ext_vector_type(4)));
typedef unsigned u32x4 __attribute__((ext_vector_type(4)));
constexpr int BM = 256, BK = 64, HALF = 128, HTB = HALF * BK * 2  , STAGE_BYTES = 8 * HTB, NXCD = 8, WGM = 8;

__host__ __device__ __forceinline__ int lds_byte(int r, int c) { const int st = (r >> 4) * 2 + (c >> 5), rr = r & 15, cc = c & 31, ob = rr * 64 + cc * 2; return st * 1024 + (ob ^ (((ob >> 9) & 1) << 5)); }
__host__ __device__ __forceinline__ void stage_rc(int b, int& R, int& C) { const int st = b / 1024, sb = b % 1024, swz = sb ^ (((sb >> 9) & 1) << 5); R = (st >> 1) * 16 + swz / 64; C = (st & 1) * 32 + (swz % 64) / 2; }
__host__ __device__ __forceinline__ int perm32(int rho) { const int n = rho >> 4, i = rho & 15; return 8 * (i >> 2) + 4 * n + (i & 3); }

struct Unit { int pm, pn; };
struct Gemm { const bf16_t* A; const bf16_t* Bt; int M, N, K; };

struct StaticOrder {
    int nM, nN, nwg, G, c;
    __host__ __device__ void init(int M, int N, int G_, int c_) { nM = M / BM; nN = N / BM; nwg = nM * nN; G = G_; c = c_; }
    __host__ __device__ bool next(int i, Unit& u) const {
        const long L = (long)i * G + c; if (L >= nwg) return false;
        int wgid = (int)L; { const int q = nwg / NXCD, r = nwg % NXCD, xcd = wgid % NXCD, off = wgid / NXCD; wgid = (xcd < r ? xcd * (q + 1) : r * (q + 1) + (xcd - r) * q) + off; }
        const int nig = WGM * nN, gid = wgid / nig, fm = gid * WGM, gsz = (nM - fm) < WGM ? (nM - fm) : WGM;
        u.pm = fm + ((wgid % nig) % gsz); u.pn = (wgid % nig) / gsz; return true;
    }
    __device__ __forceinline__ void a_ready(const Unit&) const {}
    __device__ __forceinline__ void done(const Unit&) const {}
};

__device__ __forceinline__ unsigned cvt_pk_bf16(float lo, float hi) { unsigned r; asm volatile("v_cvt_pk_bf16_f32 %0, %1, %2" : "=v"(r) : "v"(lo), "v"(hi)); return r; }
__device__ __forceinline__ float silu_f(float g) { return g * __builtin_amdgcn_rcpf(1.0f + __builtin_amdgcn_exp2f(-1.4426950408889634f * g)); }

struct EpiSwiGLU {
    static constexpr bool PERM = true, AFTER_DRAIN = false;
    bf16_t* O; int ldc;
    __device__ __forceinline__ void operator()(const f32x4 (&acc)[2][2][4][2], const Unit& u, int wr, int wc, int fr, int fq) const {
        const int row0 = u.pm * BM + wr * 64 + fr, col0 = u.pn * HALF + wc * 32 + 8 * fq;
#pragma unroll
        for (int ai = 0; ai < 2; ++ai)
#pragma unroll
            for (int m = 0; m < 4; ++m) {
                bf16_t* rowp = O + (size_t)(row0 + ai * HALF + m * 16) * ldc + col0;
                const f32x4 g0 = acc[ai][0][m][0], g1 = acc[ai][0][m][1], u0 = acc[ai][1][m][0], u1 = acc[ai][1][m][1];
                u32x4 w;
                w.x = cvt_pk_bf16(silu_f(g0[0]) * u0[0], silu_f(g0[1]) * u0[1]); w.y = cvt_pk_bf16(silu_f(g0[2]) * u0[2], silu_f(g0[3]) * u0[3]);
                w.z = cvt_pk_bf16(silu_f(g1[0]) * u1[0], silu_f(g1[1]) * u1[1]); w.w = cvt_pk_bf16(silu_f(g1[2]) * u1[2], silu_f(g1[3]) * u1[3]);
                *(u32x4*)rowp = w;
            }
    }
};
struct EpiF32 {
    static constexpr bool PERM = false, AFTER_DRAIN = false;
    float* O; int ldc;
    __device__ __forceinline__ void operator()(const f32x4 (&acc)[2][2][4][2], const Unit& u, int wr, int wc, int fr, int fq) const {
        const int col0 = u.pn * BM + wc * 32 + 4 * fq;
#pragma unroll
        for (int ai = 0; ai < 2; ++ai)
#pragma unroll
            for (int m = 0; m < 4; ++m) { float* rowp = O + (size_t)(u.pm * BM + ai * HALF + wr * 64 + m * 16 + fr) * ldc + col0;
#pragma unroll
                for (int bj = 0; bj < 2; ++bj)
#pragma unroll
                    for (int n = 0; n < 2; ++n) *(f32x4*)(rowp + bj * HALF + n * 16) = acc[ai][bj][m][n]; }
    }
};
struct EpiWin {
    static constexpr bool PERM = true, AFTER_DRAIN = false;
    bf16_t *QB, *KB, *VB, *GB, *UB; float *OUTK, *OUTV, *OUTC; float qscale;
    __device__ __forceinline__ void operator()(const f32x4 (&acc)[2][2][4][2], const Unit& u, int wr, int wc, int fr, int fq) const {
        const int pn = u.pn, c8 = wc * 32 + 8 * fq;
#pragma unroll
        for (int ai = 0; ai < 2; ++ai)
#pragma unroll
            for (int m = 0; m < 4; ++m) {
                const int row = u.pm * BM + ai * HALF + wr * 64 + m * 16 + fr, b = row >> 13, s = row & 8191;
                if (pn >= 8) {
                    const f32x4 a0 = acc[ai][0][m][0] * acc[ai][1][m][0], a1 = acc[ai][0][m][1] * acc[ai][1][m][1];
                    const int col = (pn - 8) * HALF + c8;
                    u32x4 w; w.x = cvt_pk_bf16(a0[0], a0[1]); w.y = cvt_pk_bf16(a0[2], a0[3]); w.z = cvt_pk_bf16(a1[0], a1[1]); w.w = cvt_pk_bf16(a1[2], a1[3]);
                    *(u32x4*)(UB + (size_t)row * 512 + col) = w;
                    if (s >= 8190) { float* o = OUTC + (size_t)(b * 2 + (s - 8190)) * 512 + col; *(f32x4*)o = a0; *(f32x4*)(o + 4) = a1; }
                } else {
#pragma unroll
                    for (int bj = 0; bj < 2; ++bj) {
                        const f32x4 a0 = acc[ai][bj][m][0], a1 = acc[ai][bj][m][1];
                        const int col = (pn & 1) * BM + bj * HALF + c8;
                        if (pn < 2) { const f32x4 q0 = a0 * qscale, q1 = a1 * qscale; u32x4 w; w.x = cvt_pk_bf16(q0[0], q0[1]); w.y = cvt_pk_bf16(q0[2], q0[3]); w.z = cvt_pk_bf16(q1[0], q1[1]); w.w = cvt_pk_bf16(q1[2], q1[3]);
                            *(u32x4*)(QB + (size_t)row * 512 + col) = w; }
                        else { u32x4 w; w.x = cvt_pk_bf16(a0[0], a0[1]); w.y = cvt_pk_bf16(a0[2], a0[3]); w.z = cvt_pk_bf16(a1[0], a1[1]); w.w = cvt_pk_bf16(a1[2], a1[3]);
                            if (pn < 6) { bf16_t* kb = (pn < 4) ? KB : VB; float* of = (pn < 4) ? OUTK : OUTV;
                                *(u32x4*)(kb + (size_t)row * 512 + col) = w;
                                float* o = of + (size_t)(b * 8208 + 16 + s) * 512 + col; *(f32x4*)o = a0; *(f32x4*)(o + 4) = a1; }
                            else *(u32x4*)(GB + (size_t)row * 512 + col) = w; }
                    }
                }
            }
    }
};
template <class Epi, class Sched, bool ALIGN_EPI = false, bool SP2 = false>
__device__ __forceinline__ void gemm_phase(PG8_LAS unsigned char* lds, const Gemm g, const Sched& S, const Epi& E) {
    const int tid = threadIdx.x, wid = __builtin_amdgcn_readfirstlane(tid >> 6), lane = tid & 63, wr = wid >> 2, wc = wid & 3, fr = lane & 15, fq = lane >> 4;
    const int K = g.K, nt = K / BK;
    unsigned voffA[2], voffB[2];
#pragma unroll
    for (int i = 0; i < 2; ++i) { int R, C; stage_rc(tid * 16 + i * 8192, R, C); const int Rb = Epi::PERM ? ((R & ~31) + perm32(R & 31)) : R;
        voffA[i] = (unsigned)(R * K + C) * 2u; voffB[i] = (unsigned)(Rb * K + C) * 2u; }
    const size_t kstep = (size_t)(BK * 2);
    const size_t hstep = (size_t)HALF * K * 2;
    const size_t tstep = 2 * hstep;
    const unsigned ldsw = (unsigned)wid * 1024u;
    const int aoff = lds_byte(wr * 64 + fr, fq * 8), boff = lds_byte(wc * 32 + fr, fq * 8);
#define PG8_SA(b, h) (((b) * 2 + (h)) * HTB)
#define PG8_SB(b, h) ((4 + (b) * 2 + (h)) * HTB)
#define PG8_STAGE(bufoff, gbase, voff) do { _Pragma("unroll") for (int _i = 0; _i < 2; ++_i) \
        __builtin_amdgcn_global_load_lds((const unsigned*)((const char*)(gbase) + (voff)[_i]), (PG8_LAS unsigned*)(lds + (bufoff) + ldsw + _i * 8192), 16, 0, 0); } while (0)
#define PG8_LDA(dst, b, h) do { _Pragma("unroll") for (int m = 0; m < 4; ++m) _Pragma("unroll") for (int k = 0; k < 2; ++k) dst[m][k] = *(const PG8_LAS bf16x8*)(lds + PG8_SA(b, h) + aoff + m * 2048 + k * 1024); } while (0)
#define PG8_LDB(dst, b, h) do { _Pragma("unroll") for (int n = 0; n < 2; ++n) _Pragma("unroll") for (int k = 0; k < 2; ++k) dst[n][k] = *(const PG8_LAS bf16x8*)(lds + PG8_SB(b, h) + boff + n * 2048 + k * 1024); } while (0)
#define PG8_MMA(ai, bj, At, Bt) do { __builtin_amdgcn_s_setprio(1); _Pragma("unroll") for (int m = 0; m < 4; ++m) _Pragma("unroll") for (int n = 0; n < 2; ++n) _Pragma("unroll") for (int k = 0; k < 2; ++k) \
        acc[ai][bj][m][n] = __builtin_amdgcn_mfma_f32_16x16x32_bf16(Bt[n][k], At[m][k], acc[ai][bj][m][n], 0, 0, 0); __builtin_amdgcn_s_setprio(0); } while (0)
#define PG8_WAIT_V(n) asm volatile("s_waitcnt vmcnt(" #n ")" ::: "memory")
#define PG8_WAIT_L(n) asm volatile("s_waitcnt lgkmcnt(" #n ")" ::: "memory")
#define PG8_BAR __builtin_amdgcn_s_barrier()
#define PG8_SCHED __builtin_amdgcn_sched_barrier(0)
    Unit cur, nxt; int ui = 0;
    if (!S.next(0, cur)) return;
    f32x4 acc[2][2][4][2];
#pragma unroll
    for (int a = 0; a < 2; ++a)
#pragma unroll
        for (int b = 0; b < 2; ++b)
#pragma unroll
            for (int m = 0; m < 4; ++m)
#pragma unroll
                for (int n = 0; n < 2; ++n) acc[a][b][m][n] = (f32x4){0.f, 0.f, 0.f, 0.f};
    bf16x8 At[4][2], B0[2][2], B1[2][2];
    const char* cA = (const char*)g.A + (size_t)cur.pm * tstep; const char* cB = (const char*)g.Bt + (size_t)cur.pn * tstep;
    S.a_ready(cur);
    if constexpr (SP2) {
        PG8_STAGE(PG8_SB(0, 0), cB, voffB); PG8_STAGE(PG8_SB(0, 1), cB + hstep, voffB); PG8_STAGE(PG8_SA(0, 0), cA, voffA); PG8_STAGE(PG8_SA(0, 1), cA + hstep, voffA);
        if (wr == 1) PG8_BAR;
        PG8_WAIT_V(2); PG8_BAR;
        PG8_STAGE(PG8_SB(1, 0), cB + kstep, voffB); PG8_STAGE(PG8_SA(1, 0), cA + kstep, voffA); PG8_STAGE(PG8_SB(1, 1), cB + hstep + kstep, voffB);
        PG8_WAIT_V(6); PG8_BAR;
    } else {
        PG8_STAGE(PG8_SB(0, 0), cB, voffB); PG8_STAGE(PG8_SA(0, 0), cA, voffA); PG8_STAGE(PG8_SB(0, 1), cB + hstep, voffB); PG8_STAGE(PG8_SA(0, 1), cA + hstep, voffA);
        if (wr == 1) PG8_BAR;
        PG8_WAIT_V(4); PG8_BAR;
        PG8_STAGE(PG8_SB(1, 0), cB + kstep, voffB); PG8_STAGE(PG8_SA(1, 0), cA + kstep, voffA); PG8_STAGE(PG8_SB(1, 1), cB + hstep + kstep, voffB);
        PG8_WAIT_V(6); PG8_BAR;
    }
    for (;;) {
        const bool has_next = S.next(ui + 1, nxt);
        const char* nA = has_next ? (const char*)g.A + (size_t)nxt.pm * tstep : cA; const char* nB = has_next ? (const char*)g.Bt + (size_t)nxt.pn * tstep : cB;
        for (int t = 0; t < nt; t += 2) {
            const bool last = (t == nt - 2);
            const char* a1 = cA + (size_t)(t + 1) * kstep;
            const char* a2 = last ? nA : cA + (size_t)(t + 2) * kstep; const char* b2 = last ? nB : cB + (size_t)(t + 2) * kstep;
            const char* a3 = a2 + kstep; const char* b3 = b2 + kstep;
            if (last && has_next) S.a_ready(nxt);
            if constexpr (SP2) {
            PG8_LDB(B0, 0, 0); PG8_LDB(B1, 0, 1); PG8_SCHED; PG8_LDA(At, 0, 0); PG8_STAGE(PG8_SA(1, 1), a1 + hstep, voffA);
            PG8_WAIT_V(8); PG8_WAIT_L(0); PG8_BAR; PG8_MMA(0, 0, At, B0); PG8_MMA(0, 1, At, B1); PG8_BAR; PG8_SCHED;
            PG8_LDA(At, 0, 1); PG8_STAGE(PG8_SB(0, 0), b2, voffB); PG8_STAGE(PG8_SB(0, 1), b2 + hstep, voffB); PG8_STAGE(PG8_SA(0, 0), a2, voffA);
            PG8_WAIT_V(8); PG8_WAIT_L(0); PG8_BAR; PG8_MMA(1, 0, At, B0); PG8_MMA(1, 1, At, B1); PG8_BAR; PG8_SCHED;
            PG8_LDB(B0, 1, 0); PG8_LDB(B1, 1, 1); PG8_SCHED; PG8_LDA(At, 1, 0); PG8_STAGE(PG8_SA(0, 1), a2 + hstep, voffA);
            PG8_WAIT_V(8); PG8_WAIT_L(0); PG8_BAR; PG8_MMA(0, 0, At, B0); PG8_MMA(0, 1, At, B1); PG8_BAR; PG8_SCHED;
            PG8_LDA(At, 1, 1); PG8_STAGE(PG8_SB(1, 0), b3, voffB); PG8_STAGE(PG8_SB(1, 1), b3 + hstep, voffB); PG8_STAGE(PG8_SA(1, 0), a3, voffA);
            PG8_WAIT_V(8); PG8_WAIT_L(0); PG8_BAR; PG8_MMA(1, 0, At, B0); PG8_MMA(1, 1, At, B1); PG8_BAR; PG8_SCHED;
            } else {
            PG8_LDB(B0, 0, 0); PG8_SCHED; PG8_LDA(At, 0, 0); PG8_STAGE(PG8_SA(1, 1), a1 + hstep, voffA);
            PG8_WAIT_L(8); PG8_BAR; PG8_WAIT_L(0); PG8_MMA(0, 0, At, B0); PG8_BAR; PG8_SCHED;
            PG8_LDB(B1, 0, 1); PG8_STAGE(PG8_SB(0, 0), b2, voffB);
            PG8_BAR; PG8_WAIT_L(0); PG8_MMA(0, 1, At, B1); PG8_BAR;
            PG8_LDA(At, 0, 1); PG8_STAGE(PG8_SA(0, 0), a2, voffA);
            PG8_BAR; PG8_WAIT_L(0); PG8_MMA(1, 0, At, B0); PG8_BAR; PG8_SCHED;
            PG8_STAGE(PG8_SB(0, 1), b2 + hstep, voffB);
            PG8_WAIT_V(6); PG8_BAR; PG8_MMA(1, 1, At, B1); PG8_BAR;
            PG8_LDB(B0, 1, 0); PG8_SCHED; PG8_LDA(At, 1, 0); PG8_STAGE(PG8_SA(0, 1), a2 + hstep, voffA);
            PG8_WAIT_L(8); PG8_BAR; PG8_WAIT_L(0); PG8_MMA(0, 0, At, B0); PG8_BAR; PG8_SCHED;
            PG8_LDB(B1, 1, 1); PG8_STAGE(PG8_SB(1, 0), b3, voffB);
            PG8_BAR; PG8_WAIT_L(0); PG8_MMA(0, 1, At, B1); PG8_BAR;
            PG8_LDA(At, 1, 1); PG8_STAGE(PG8_SA(1, 0), a3, voffA);
            PG8_BAR; PG8_WAIT_L(0); PG8_MMA(1, 0, At, B0); PG8_BAR; PG8_SCHED;
            PG8_STAGE(PG8_SB(1, 1), b3 + hstep, voffB);
            PG8_WAIT_V(6); PG8_BAR; PG8_MMA(1, 1, At, B1); PG8_BAR;
            }
        }
        if constexpr (ALIGN_EPI) { if (wr == 0) PG8_BAR; }
        if constexpr (!Epi::AFTER_DRAIN) { E(acc, cur, wr, wc, fr, fq); S.done(cur); }
        if (!has_next) break;
#pragma unroll
        for (int a = 0; a < 2; ++a)
#pragma unroll
            for (int b = 0; b < 2; ++b)
#pragma unroll
                for (int m = 0; m < 4; ++m)
#pragma unroll
                    for (int n = 0; n < 2; ++n) acc[a][b][m][n] = (f32x4){0.f, 0.f, 0.f, 0.f};
        cur = nxt; cA = nA; cB = nB; ++ui;
        if constexpr (ALIGN_EPI) { if (wr == 1) PG8_BAR; }
    }
    PG8_WAIT_V(0);
    if constexpr (!ALIGN_EPI) { if (wr == 0) PG8_BAR; }
    PG8_BAR;
    if constexpr (Epi::AFTER_DRAIN) { E.fused(acc, cur, wr, wc, fr, fq, lds, wid, lane); S.done(cur); }
#undef PG8_SA
#undef PG8_SB
#undef PG8_STAGE
#undef PG8_LDA
#undef PG8_LDB
#undef PG8_MMA
#undef PG8_WAIT_V
#undef PG8_WAIT_L
#undef PG8_BAR
#undef PG8_SCHED
}
}

#ifndef PG8_SP2
#define PG8_SP2 true
#endif
#ifndef PG8_ALIGN
#define PG8_ALIGN true
#endif
#include <hip/hip_bf16.h>
#include <cmath>
namespace attn_body {
using bf16=__hip_bfloat16;
using bf16x8=__attribute__((ext_vector_type(8)))short;
using s16x4=__attribute__((ext_vector_type(4)))short;
using f32x16=__attribute__((ext_vector_type(16)))float;
using u32x4=__attribute__((ext_vector_type(4)))unsigned;
constexpr int SEQ=8192,D=64,DM=512;
constexpr int NW=8,QBLK=32,QB=QBLK*NW,KVBLK=64,NQB=SEQ/QB;
constexpr int ATTN_PITCH=DM, ATTN_UNIT_ROWS=QB;
__device__ __forceinline__ int crow(int r,int hi){return (r&3)+8*(r>>2)+4*hi;}
#define SBAR() __builtin_amdgcn_sched_barrier(0)
__device__ __forceinline__ void cmask(f32x16&p0,f32x16&p1,int jb,int qrel,int hi){
  const float NEG=-INFINITY; int kb=64*jb+4*hi;
  #pragma unroll
  for(int r=0;r<16;++r){int kv=kb+(r&3)+8*(r>>2); if(kv>qrel)p0[r]=NEG; if(kv+32>qrel)p1[r]=NEG;}
}

constexpr int NSLOT=3, SLOTB=8192;
constexpr int LDS_K=0, LDS_V=NSLOT*SLOTB, LDS_WS=2*NSLOT*SLOTB, LDS_OST=LDS_WS+NW*64*4, LDS_HK=LDS_OST+NW*4096, LDS_HV=LDS_HK+SLOTB, LDS_BYTES=LDS_HV+SLOTB;
constexpr float C2=0.125f*1.4426950408889634f;
__device__ __forceinline__ void glds16(const void*gsrc,unsigned lds_dst){unsigned keep;
  asm volatile("s_mov_b32 %0, m0\n\ts_mov_b32 m0, %2\n\ts_nop 0\n\tglobal_load_lds_dwordx4 %1, off\n\ts_mov_b32 m0, %0":"=&s"(keep):"v"(gsrc),"s"(lds_dst):"memory");}
__device__ __forceinline__ float max3f(float a,float b,float c){float r;asm("v_max3_f32 %0, %1, %2, %3":"=v"(r):"v"(a),"v"(b),"v"(c));return r;}
__device__ __forceinline__ float max2f(float a,float b){float r;asm("v_max_f32_e32 %0, %1, %2":"=v"(r):"v"(a),"v"(b));return r;}
__device__ __forceinline__ float fadd_s(float a,float b){float r;asm("v_add_f32_e32 %0, %1, %2":"=v"(r):"v"(a),"v"(b));return r;}
__device__ __forceinline__ float fsub_s(float a,float b){float r;asm("v_sub_f32_e32 %0, %1, %2":"=v"(r):"v"(a),"v"(b));return r;}
typedef float f32x2_t __attribute__((ext_vector_type(2))); typedef __bf16 bf16x2_t __attribute__((ext_vector_type(2)));
__device__ __forceinline__ unsigned cvtpk_s(float lo,float hi){f32x2_t v={lo,hi};bf16x2_t b=__builtin_convertvector(v,bf16x2_t);return __builtin_bit_cast(unsigned,b);}
#define WAIT_BAR(N) asm volatile("s_waitcnt vmcnt(" #N ") lgkmcnt(0)\n\ts_barrier":::"memory")

__device__ __forceinline__ void hmask(f32x16&p0,f32x16&p1){ const float NEG=-INFINITY;
  #pragma unroll
  for(int r=0;r<16;++r){ if(r>=8)p0[r]=NEG; p1[r]=NEG; } }
__device__ __forceinline__ void qkt(f32x16&p0,f32x16&p1,const char*Kslot,const bf16x8*qr,const f32x16&negm,int r32,int hi){
  const char*kb=Kslot+hi*1024+r32*16;
  #pragma unroll
  for(int d0=0;d0<4;++d0){
    const bf16x8 b0=*reinterpret_cast<const bf16x8*>(kb+d0*2048);
    const bf16x8 b1=*reinterpret_cast<const bf16x8*>(kb+d0*2048+512);
    if(d0==0){p0=__builtin_amdgcn_mfma_f32_32x32x16_bf16(b0,qr[0],negm,0,0,0);p1=__builtin_amdgcn_mfma_f32_32x32x16_bf16(b1,qr[0],negm,0,0,0);}
    else{p0=__builtin_amdgcn_mfma_f32_32x32x16_bf16(b0,qr[d0],p0,0,0,0);p1=__builtin_amdgcn_mfma_f32_32x32x16_bf16(b1,qr[d0],p1,0,0,0);}}
}
typedef __attribute__((address_space(3))) const char* lds_cptr;
typedef short v4i16_t __attribute__((ext_vector_type(4)));
__device__ __forceinline__ void kload8(bf16x8*kf,lds_cptr kp){
  kf[0]=*(const __attribute__((address_space(3))) bf16x8*)(kp);      kf[1]=*(const __attribute__((address_space(3))) bf16x8*)(kp+512);
  kf[2]=*(const __attribute__((address_space(3))) bf16x8*)(kp+2048); kf[3]=*(const __attribute__((address_space(3))) bf16x8*)(kp+2560);
  kf[4]=*(const __attribute__((address_space(3))) bf16x8*)(kp+4096); kf[5]=*(const __attribute__((address_space(3))) bf16x8*)(kp+4608);
  kf[6]=*(const __attribute__((address_space(3))) bf16x8*)(kp+6144); kf[7]=*(const __attribute__((address_space(3))) bf16x8*)(kp+6656);
}
__device__ __forceinline__ void kload2(bf16x8*kf,lds_cptr kp,int j){ kf[2*j]=*(const __attribute__((address_space(3))) bf16x8*)(kp+j*2048); kf[2*j+1]=*(const __attribute__((address_space(3))) bf16x8*)(kp+j*2048+512); }
__device__ __forceinline__ s16x4 vtr(lds_cptr p){ return __builtin_bit_cast(s16x4,__builtin_amdgcn_ds_read_tr16_b64_v4i16((__attribute__((address_space(3))) v4i16_t*)p)); }
__device__ __forceinline__ float rowmax(const f32x16&p0,const f32x16&p1){
  float a=max3f(p0[0],p0[1],p1[0]),b=max3f(p0[2],p0[3],p1[1]);a=max3f(a,p1[2],p1[3]);
  #pragma unroll
  for(int r=4;r<16;r+=4){a=max3f(a,p0[r],p0[r+1]);b=max3f(b,p0[r+2],p0[r+3]);a=max3f(a,p1[r],p1[r+1]);b=max3f(b,p1[r+2],p1[r+3]);}
  const float m=max2f(a,b);
  auto rr=__builtin_amdgcn_permlane32_swap(__float_as_uint(m),__float_as_uint(m),false,false);
  return max2f(__uint_as_float(rr[0]),__uint_as_float(rr[1]));
}
__device__ __forceinline__ void pv(f32x16*o,int vb,bf16x8 pa0,bf16x8 pa1,bf16x8 pa2,bf16x8 pa3){
  #pragma unroll
  for(int d0=0;d0<2;++d0){s16x4 lo[4],hi[4];
    #pragma unroll
    for(int ks=0;ks<4;++ks){
      asm volatile("ds_read_b64_tr_b16 %0,%1 offset:%c2":"=&v"(lo[ks]):"v"(vb),"i"(d0*4096+ks*1024):"memory");
      asm volatile("ds_read_b64_tr_b16 %0,%1 offset:%c2":"=&v"(hi[ks]):"v"(vb),"i"(d0*4096+ks*1024+512):"memory");}
    asm volatile("s_waitcnt lgkmcnt(0)":::"memory");SBAR();
    #define PK(k) (bf16x8){lo[k][0],lo[k][1],lo[k][2],lo[k][3],hi[k][0],hi[k][1],hi[k][2],hi[k][3]}
    o[d0]=__builtin_amdgcn_mfma_f32_32x32x16_bf16(pa0,PK(0),o[d0],0,0,0);
    o[d0]=__builtin_amdgcn_mfma_f32_32x32x16_bf16(pa1,PK(1),o[d0],0,0,0);
    o[d0]=__builtin_amdgcn_mfma_f32_32x32x16_bf16(pa2,PK(2),o[d0],0,0,0);
    o[d0]=__builtin_amdgcn_mfma_f32_32x32x16_bf16(pa3,PK(3),o[d0],0,0,0);
    #undef PK
  }
}

#ifndef ATTN_STORE16
#define ATTN_STORE16(p,v) (*(u32x4*)(p)=(v))
#endif
template<int THRL> __device__ __forceinline__ void attn_unit(int qb,const bf16*Qu,const bf16*__restrict__ Ku,const bf16*__restrict__ Vu,const bf16*__restrict__ KHu,const bf16*__restrict__ VHu,bf16*Ou,char*shm){
  const int tid=threadIdx.x,lane=tid&63,r32=lane&31,hi=lane>>5; const int wid=__builtin_amdgcn_readfirstlane(tid>>6);
  const int q0=qb*QB;
  const bf16*Qw=Qu+(long)(q0+wid*QBLK)*DM;
  const bf16*Kh=Ku,*Vh=Vu;
  const unsigned lds0=(unsigned)(uintptr_t)shm;
  float*wsf=(float*)(shm+LDS_WS)+wid*64;
  const bf16*ksrc=Kh+(long)lane*DM+wid*8;
  const bf16*vsrc=Vh+(long)(16*(wid&3)+(lane>>2))*DM+(wid>>2)*32+(lane&3)*8;
  const unsigned kdst=lds0+LDS_K+wid*1024, vdst=lds0+LDS_V+wid*1024;
  #define DMA_K(t,slot) glds16(ksrc+(long)(t)*KVBLK*DM,(unsigned)__builtin_amdgcn_readfirstlane(kdst+(slot)))
  #define DMA_V(t,slot) glds16(vsrc+(long)(t)*KVBLK*DM,(unsigned)__builtin_amdgcn_readfirstlane(vdst+(slot)))
  const int vb0=(int)(lds0+LDS_V)+((lane>>4)&1)*32+(lane&3)*8+(4*hi+((lane&15)>>2))*64;
  const char*Kbase=shm+LDS_K; bf16x8 kf[8];
  const lds_cptr shm3=(lds_cptr)shm; const lds_cptr kp0=shm3+LDS_K+hi*1024+r32*16; const lds_cptr vp0=shm3+LDS_V+((lane>>4)&1)*32+(lane&3)*8+(4*hi+((lane&15)>>2))*64;
  const int NT=(q0+QB)/KVBLK;
  glds16(KHu+(long)lane*DM+wid*8,(unsigned)__builtin_amdgcn_readfirstlane(lds0+LDS_HK+wid*1024));
  glds16(VHu+(long)(16*(wid&3)+(lane>>2))*DM+(wid>>2)*32+(lane&3)*8,(unsigned)__builtin_amdgcn_readfirstlane(lds0+LDS_HV+wid*1024));
  DMA_K(0,0);DMA_V(0,0);DMA_K(1,SLOTB);
  bf16x8 qr[4];
  #pragma unroll
  for(int d0=0;d0<4;++d0)qr[d0]=*reinterpret_cast<const bf16x8*>(&Qw[(long)r32*DM+d0*16+hi*8]);
  float mhat=0.f,l_reg=0.f;f32x16 o[2];o[0]=f32x16{};o[1]=f32x16{};f32x16 negm=f32x16{};asm volatile("":"+v"(negm));
  const int qrel=wid*QBLK+r32;
  #define CMASK(P0,P1,t) do{int jb_=(t)-(NT-4); if(jb_>=0)cmask(P0,P1,jb_,qrel,hi);}while(0)
  bool resc=false;
  #define START(P0,P1) do{ const float rm=rowmax(P0,P1); resc=false; \
    { const float dl=rm; mhat=fadd_s(mhat,dl); \
      _Pragma("unroll") for(int r=0;r<16;++r){P0[r]=fsub_s(P0[r],dl);P1[r]=fsub_s(P1[r],dl);} \
      _Pragma("unroll") for(int r=0;r<16;++r)negm[r]=-mhat; asm volatile("":"+v"(negm)); } \
    _Pragma("unroll") for(int r=0;r<16;++r)P0[r]=__builtin_amdgcn_exp2f(P0[r]); }while(0)
  #define RESC() do{ if(resc){ asm volatile("s_waitcnt lgkmcnt(0)":::"memory"); \
      _Pragma("unroll") for(int d_=0;d_<2;++d_) _Pragma("unroll") for(int r=0;r<16;++r)o[d_][r]*=wsf[crow(r,hi)]; } }while(0)
  f32x16 pA0,pA1,pB0,pB1;
  int sl_prev=0,sl_cur=0,sl_next=SLOTB;
  #define ROT() do{sl_prev=sl_cur;sl_cur=sl_next;sl_next=(sl_next==(NSLOT-1)*SLOTB)?0:sl_next+SLOTB;}while(0)
  DMA_K(2,2*SLOTB);
  WAIT_BAR(3);
  qkt(pA0,pA1,Kbase,qr,negm,r32,hi);asm volatile("s_nop 15\n\ts_nop 7":"+v"(pA0),"+v"(pA1));CMASK(pA0,pA1,0);
  START(pA0,pA1);
  _Pragma("unroll") for(int r=0;r<16;++r)pA1[r]=__builtin_amdgcn_exp2f(pA1[r]);
  WAIT_BAR(0);
  DMA_K(3,0);DMA_V(1,SLOTB);
  ROT();
  kload8(kf,kp0+sl_cur);
  WAIT_BAR(2);
  s16x4 vlo[8],vhi[8]; u32x4 pw0,pw1,pw2,pw3;
  #define PKW(P,B) cvtpk_s(P[B],P[B+1])
  #define PAF(k) __builtin_bit_cast(bf16x8,pw##k)
  #define VFR(i) (bf16x8){vlo[i][0],vlo[i][1],vlo[i][2],vlo[i][3],vhi[i][0],vhi[i][1],vhi[i][2],vhi[i][3]}
  #define PIN(x) asm volatile("":"+v"(x))
  #define MX3(a,b,c) __builtin_fmaxf(__builtin_fmaxf((a),(b)),(c))
  #define GAPA(MF,A0,A1,A2,A3,W0,W1,PW) do{ MF; sacc+=A0; sacc+=A1; sacc+=A2; sacc+=A3; PIN(sacc); W0; W1; PIN(PW); SBAR(); }while(0)
  #define EX(v) __builtin_amdgcn_exp2f(v)
  #define GAPB(MF,X,B) do{ MF; X[B]=EX(X[B]); X[B+1]=EX(X[B+1]); X[B+2]=EX(X[B+2]); X[B+3]=EX(X[B+3]); PIN(X); SBAR(); }while(0)
  #define VRD(i) do{ vlo[i]=vtr(vp_+(((i)>>2)*4096+((i)&3)*1024)); vhi[i]=vtr(vp_+(((i)>>2)*4096+((i)&3)*1024+512)); }while(0)
  #define KRD(G,j) do{ if(G){ kload2(kf,kp0+sl_next,j); SBAR(); } }while(0)
  #define STEP(C0,C1,P0,P1,t,GK,GV,GL) do{ SBAR(); \
    const lds_cptr vp_=vp0+sl_prev; \
    VRD(0); SBAR(); float sacc=(P0[0]+P0[1]); \
    GAPA(C0=__builtin_amdgcn_mfma_f32_32x32x16_bf16(kf[0],qr[0],negm,0,0,0), P0[2],P0[3],P0[4],P0[5],     pw0[0]=PKW(P0,0), pw0[1]=PKW(P0,2), pw0); \
    VRD(4); SBAR(); GAPA(C1=__builtin_amdgcn_mfma_f32_32x32x16_bf16(kf[1],qr[0],negm,0,0,0), P0[6],P0[7],P0[8],P0[9],     pw0[2]=PKW(P0,4), pw0[3]=PKW(P0,6), pw0); \
    VRD(1); SBAR(); GAPA(C0=__builtin_amdgcn_mfma_f32_32x32x16_bf16(kf[2],qr[1],C0,0,0,0),   P0[10],P0[11],P0[12],P0[13], pw1[0]=PKW(P0,8), pw1[1]=PKW(P0,10), pw1); \
    VRD(5); SBAR(); GAPA(C1=__builtin_amdgcn_mfma_f32_32x32x16_bf16(kf[3],qr[1],C1,0,0,0),   P0[14],P0[15],P1[0],P1[1],   pw1[2]=PKW(P0,12),pw1[3]=PKW(P0,14), pw1); \
    VRD(2); SBAR(); GAPA(C0=__builtin_amdgcn_mfma_f32_32x32x16_bf16(kf[4],qr[2],C0,0,0,0),   P1[2],P1[3],P1[4],P1[5],     pw2[0]=PKW(P1,0), pw2[1]=PKW(P1,2), pw2); \
    VRD(6); SBAR(); GAPA(C1=__builtin_amdgcn_mfma_f32_32x32x16_bf16(kf[5],qr[2],C1,0,0,0),   P1[6],P1[7],P1[8],P1[9],     pw2[2]=PKW(P1,4), pw2[3]=PKW(P1,6), pw2); \
    VRD(3); SBAR(); GAPA(C0=__builtin_amdgcn_mfma_f32_32x32x16_bf16(kf[6],qr[3],C0,0,0,0),   P1[10],P1[11],P1[12],P1[13], pw3[0]=PKW(P1,8), pw3[1]=PKW(P1,10), pw3); \
    VRD(7); SBAR(); GAPA(C1=__builtin_amdgcn_mfma_f32_32x32x16_bf16(kf[7],qr[3],C1,0,0,0),   P1[14],P1[15],0.f,0.f,       pw3[2]=PKW(P1,12),pw3[3]=PKW(P1,14), pw3); \
    l_reg+=sacc; \
    if(GK){DMA_K((t)+3,sl_cur);} if(GV){DMA_V((t)+1,sl_next);} \
    CMASK(C0,C1,t); \
    { float a=MX3(C0[0],C0[1],C1[0]),b=MX3(C0[2],C0[3],C1[1]); a=MX3(a,C1[2],C1[3]); \
      _Pragma("unroll") for(int r=4;r<16;r+=4){a=MX3(a,C0[r],C0[r+1]);b=MX3(b,C0[r+2],C0[r+3]);a=MX3(a,C1[r],C1[r+1]);b=MX3(b,C1[r+2],C1[r+3]);} \
      float rm=__builtin_fmaxf(a,b); { auto rr=__builtin_amdgcn_permlane32_swap(__float_as_uint(rm),__float_as_uint(rm),false,false); rm=__builtin_fmaxf(__uint_as_float(rr[0]),__uint_as_float(rr[1])); } \
      resc=false; \
      if(__builtin_expect(__any(rm>(float)THRL),0)){ const float dl=__builtin_fmaxf(rm,0.f); mhat+=dl; \
        _Pragma("unroll") for(int r=0;r<16;++r){C0[r]-=dl;C1[r]-=dl;} \
        _Pragma("unroll") for(int r=0;r<16;++r)negm[r]=-mhat; asm volatile("":"+v"(negm)); \
        const float f=__builtin_amdgcn_exp2f(-dl); l_reg*=f; if(hi==0)wsf[r32]=f; resc=true; } } \
    SBAR(); \
    GAPB(o[0]=__builtin_amdgcn_mfma_f32_32x32x16_bf16(PAF(0),VFR(0),o[0],0,0,0), C0,0); \
    GAPB(o[1]=__builtin_amdgcn_mfma_f32_32x32x16_bf16(PAF(0),VFR(4),o[1],0,0,0), C0,4); \
    KRD(GL,0); GAPB(o[0]=__builtin_amdgcn_mfma_f32_32x32x16_bf16(PAF(1),VFR(1),o[0],0,0,0), C0,8); \
    KRD(GL,1); GAPB(o[1]=__builtin_amdgcn_mfma_f32_32x32x16_bf16(PAF(1),VFR(5),o[1],0,0,0), C0,12); \
    KRD(GL,2); GAPB(o[0]=__builtin_amdgcn_mfma_f32_32x32x16_bf16(PAF(2),VFR(2),o[0],0,0,0), C1,0); \
    KRD(GL,3); GAPB(o[1]=__builtin_amdgcn_mfma_f32_32x32x16_bf16(PAF(2),VFR(6),o[1],0,0,0), C1,4); \
    GAPB(o[0]=__builtin_amdgcn_mfma_f32_32x32x16_bf16(PAF(3),VFR(3),o[0],0,0,0), C1,8); \
    GAPB(o[1]=__builtin_amdgcn_mfma_f32_32x32x16_bf16(PAF(3),VFR(7),o[1],0,0,0), C1,12); \
    }while(0)
  int t=1;
  #undef CMASK
  #define CMASK(P0,P1,t) do{}while(0)
  for(;t+5<NT;t+=2){
    STEP(pB0,pB1,pA0,pA1,t,true,true,true);     WAIT_BAR(2); RESC(); ROT();
    STEP(pA0,pA1,pB0,pB1,t+1,true,true,true);   WAIT_BAR(2); RESC(); ROT();
  }
  #undef CMASK
  #define CMASK(P0,P1,t) do{int jb_=(t)-(NT-4); if(jb_>=0)cmask(P0,P1,jb_,qrel,hi);}while(0)
  #define ENDW(tt) do{ if((tt)+3<NT){WAIT_BAR(2);} else if((tt)+2<NT){WAIT_BAR(1);} else {WAIT_BAR(0);} }while(0)
  for(;t+1<NT;t+=2){
    STEP(pB0,pB1,pA0,pA1,t,(t+3<NT),(t+1<NT),(t+1<NT));       ENDW(t);   RESC(); ROT();
    STEP(pA0,pA1,pB0,pB1,t+1,(t+4<NT),(t+2<NT),(t+2<NT));     ENDW(t+1); RESC(); ROT();
  }
  STEP(pB0,pB1,pA0,pA1,NT-1,false,false,false); RESC();
  { float sacc=pB0[0]+pB0[1]; _Pragma("unroll") for(int r=2;r<16;++r)sacc+=pB0[r]; _Pragma("unroll") for(int r=0;r<16;++r)sacc+=pB1[r]; l_reg+=sacc;
    pw0=(u32x4){PKW(pB0,0),PKW(pB0,2),PKW(pB0,4),PKW(pB0,6)};pw1=(u32x4){PKW(pB0,8),PKW(pB0,10),PKW(pB0,12),PKW(pB0,14)};pw2=(u32x4){PKW(pB1,0),PKW(pB1,2),PKW(pB1,4),PKW(pB1,6)};pw3=(u32x4){PKW(pB1,8),PKW(pB1,10),PKW(pB1,12),PKW(pB1,14)};
    SBAR(); pv(o,vb0+sl_cur,PAF(0),PAF(1),PAF(2),PAF(3)); }
  { qkt(pA0,pA1,shm+LDS_HK,qr,negm,r32,hi);asm volatile("s_nop 15\n\ts_nop 7":"+v"(pA0),"+v"(pA1));hmask(pA0,pA1);
    const float rm=rowmax(pA0,pA1); const float dl=__builtin_fmaxf(rm,0.f);
    _Pragma("unroll") for(int r=0;r<16;++r){pA0[r]=__builtin_amdgcn_exp2f(pA0[r]-dl);pA1[r]=__builtin_amdgcn_exp2f(pA1[r]-dl);}
    const float f=__builtin_amdgcn_exp2f(-dl); l_reg*=f; if(hi==0)wsf[r32]=f; asm volatile("s_waitcnt lgkmcnt(0)":::"memory");
    _Pragma("unroll") for(int d_=0;d_<2;++d_) _Pragma("unroll") for(int r=0;r<16;++r)o[d_][r]*=wsf[crow(r,hi)];
    float sacc=pA0[0]+pA0[1]; _Pragma("unroll") for(int r=2;r<16;++r)sacc+=pA0[r]; _Pragma("unroll") for(int r=0;r<16;++r)sacc+=pA1[r]; l_reg+=sacc;
    pw0=(u32x4){PKW(pA0,0),PKW(pA0,2),PKW(pA0,4),PKW(pA0,6)};pw1=(u32x4){PKW(pA0,8),PKW(pA0,10),PKW(pA0,12),PKW(pA0,14)};pw2=(u32x4){PKW(pA1,0),PKW(pA1,2),PKW(pA1,4),PKW(pA1,6)};pw3=(u32x4){PKW(pA1,8),PKW(pA1,10),PKW(pA1,12),PKW(pA1,14)};
    SBAR(); pv(o,vb0+(LDS_HV-LDS_V),PAF(0),PAF(1),PAF(2),PAF(3)); }
  #undef PKW
  #undef PAF
  #undef VFR
  #undef PIN
  #undef MX3
  #undef GAPA
  #undef GAPB
  #undef EX
  #undef VRD
  #undef KRD
  #undef STEP
  #undef ENDW
  {auto rr=__builtin_amdgcn_permlane32_swap(__float_as_uint(l_reg),__float_as_uint(l_reg),false,false);l_reg=__uint_as_float(rr[0])+__uint_as_float(rr[1]);}
  if(hi==0)wsf[32+r32]=l_reg;asm volatile("s_waitcnt lgkmcnt(0)":::"memory");
  float rli[16];
  #pragma unroll
  for(int r=0;r<16;++r)rli[r]=__builtin_amdgcn_rcpf(wsf[32+crow(r,hi)]);
  bf16*Ow=Ou+(long)(q0+wid*QBLK)*DM;
  { bf16*stg=(bf16*)(shm+LDS_OST)+wid*2048;
    #pragma unroll
    for(int r=0;r<16;++r){const int orow=crow(r,hi);
      #pragma unroll
      for(int d0=0;d0<2;++d0)stg[orow*64+d0*32+r32]=__float2bfloat16(o[d0][r]*rli[r]);}
    asm volatile("s_waitcnt lgkmcnt(0)":::"memory");
    #pragma unroll
    for(int i=0;i<4;++i){const int row=i*8+(lane>>3),ch=lane&7; const u32x4 v=*(const u32x4*)(stg+row*64+ch*8); ATTN_STORE16(Ow+(long)row*DM+ch*8,v);} }
  asm volatile("s_waitcnt lgkmcnt(0)\n\ts_barrier":::"memory");
  #undef DMA_K
  #undef DMA_V
  #undef CMASK
  #undef START
  #undef RESC
  #undef ROT
}
constexpr int ATTN_LDS_BYTES=LDS_BYTES;
struct AttnTensors { const bf16* Q; const bf16* K; const bf16* V; const bf16* KH; const bf16* VH; bf16* O1; bf16* O2; };
struct AttnUnit { int bh; int qb; };
struct StaticOrder {
  int vcu;
  __device__ __forceinline__ explicit StaticOrder(int grid,int block):vcu((block%8)*(grid/8)+block/8){}
  __device__ __forceinline__ bool next(int i,AttnUnit&u)const{ if(i>=4)return false; const int s=vcu&7; u.bh=vcu>>3; u.qb=(i==0)?s:(i==1)?15-s:(i==2)?16+s:31-s; return true; }
  __device__ __forceinline__ void a_ready(const AttnUnit&)const{}
  __device__ __forceinline__ void done(const AttnUnit&)const{}
};
template<class Sched,int THRL=8> __device__ __forceinline__ void attn_phase(char*lds,const AttnTensors&T,const Sched&S){
  AttnUnit u;
  for(int i=0;S.next(i,u);++i){ S.a_ready(u); const int vh=u.bh&1,c=(u.bh>>1)&1,h=(u.bh>>2)&3,b=u.bh>>4;
    attn_unit<THRL>(u.qb,T.Q+(long)b*SEQ*DM+h*128+c*64,T.K+(long)b*SEQ*DM+h*128+c*64,T.V+(long)b*SEQ*DM+h*128+vh*64,T.KH+(long)b*64*DM+h*128+c*64,T.VH+(long)b*64*DM+h*128+vh*64,(c?T.O2:T.O1)+(long)b*SEQ*DM+h*128+vh*64,lds); S.done(u); }
}
#undef SBAR
#undef WAIT_BAR
}
#define GAS __attribute__((address_space(1)))
#define LAS __attribute__((address_space(3)))
typedef unsigned short bf16;
typedef unsigned v4u __attribute__((ext_vector_type(4)));
typedef float f32x4 __attribute__((ext_vector_type(4)));
typedef short bf16x8 __attribute__((ext_vector_type(8)));
typedef GAS unsigned gu32;
typedef GAS unsigned long long gu64;
#define RLX_AGENT __ATOMIC_RELAXED, __HIP_MEMORY_SCOPE_AGENT
#define LDS_WAIT() asm volatile("s_waitcnt lgkmcnt(0)" ::: "memory")
#define VM_WAIT() asm volatile("s_waitcnt vmcnt(0)" ::: "memory")
__device__ __forceinline__ unsigned long long rt() { return __builtin_amdgcn_s_memrealtime(); }
__device__ __forceinline__ unsigned f2bf(float f) { unsigned u = __builtin_bit_cast(unsigned, f); return (u + 0x7fffu + ((u >> 16) & 1u)) >> 16; }
__device__ __forceinline__ unsigned pk2(float lo, float hi) { return f2bf(lo) | (f2bf(hi) << 16); }

#define XB_TMO      128
#define XB_XCNT(j)  (256  + 64 * (j))
#define XB_XSUB(j)  (1280 + 64 * (j))
#define XB_XGEN(j)  (2304 + 64 * (j))
#define XB_TOP      3328
#define XB_TOPGEN   3392
#define XCD_BAR_WORDS 3456
#define XB_SPIN_CAP (1u << 18)

__device__ __forceinline__ unsigned xb_ld(unsigned* p)              { return __hip_atomic_load(p, __ATOMIC_RELAXED, __HIP_MEMORY_SCOPE_AGENT); }
__device__ __forceinline__ unsigned xb_add(unsigned* p, unsigned v) { return __hip_atomic_fetch_add(p, v, __ATOMIC_RELAXED, __HIP_MEMORY_SCOPE_AGENT); }
__device__ __forceinline__ unsigned xb_xcc_id() { return (unsigned)__builtin_amdgcn_s_getreg((3 << 11) | 20) & 0xFu; }
#define XB_SPIN(cond, bar) do { unsigned _sp = 0; while (cond) { __builtin_amdgcn_s_sleep(1); \
    if ((++_sp & 255u) == 0u) { if (xb_ld(&(bar)[XB_TMO])) break; if (_sp > XB_SPIN_CAP) { atomicAdd(&(bar)[XB_TMO], 1u); break; } } } } while (0)

struct XcdBarrier {
    unsigned* bar; unsigned x;
    volatile LAS unsigned* st;
};

__device__ __forceinline__ XcdBarrier xcd_barrier_post(unsigned* bar, volatile LAS unsigned* st) {
    XcdBarrier b; b.bar = bar; b.x = xb_xcc_id(); b.st = st;
    if (threadIdx.x == 0) (void)xb_add(&bar[XB_XCNT(b.x)], 1u);
    return b;
}
__device__ __forceinline__ void xcd_barrier_complete(unsigned* bar, unsigned x, unsigned& nloc, unsigned& nx) {
    const unsigned G = gridDim.x * gridDim.y * gridDim.z;
    unsigned sum, cnt, mine, sp = 0u;
    for (;;) {
        sum = 0u; cnt = 0u; mine = 0u;
#pragma unroll
        for (unsigned j = 0; j < 16; ++j) { const unsigned c = xb_ld(&bar[XB_XCNT(j)]); sum += c; cnt += (c > 0u) ? 1u : 0u; mine = (j == x) ? c : mine; }
        if (sum == G) break;
        __builtin_amdgcn_s_sleep(1);
        if ((++sp & 255u) == 0u) { if (xb_ld(&bar[XB_TMO])) break; if (sp > XB_SPIN_CAP) { atomicAdd(&bar[XB_TMO], 1u); break; } }
    }
    nloc = mine > 0u ? mine : 1u; nx = cnt > 0u ? cnt : 1u;
}

__device__ __forceinline__ void xcd_barrier(const XcdBarrier& b) {
    asm volatile("s_waitcnt vmcnt(0)" ::: "memory");
    __syncthreads();
    if (threadIdx.x == 0) {
        unsigned* bar = b.bar;
        __builtin_amdgcn_s_waitcnt(0);
        unsigned nloc = b.st[0], nx = b.st[1];
        if (nloc == 0u) { xcd_barrier_complete(bar, b.x, nloc, nx); b.st[0] = nloc; b.st[1] = nx; }
        const unsigned old = xb_add(&bar[XB_XSUB(b.x)], 1u);
        const unsigned gen = old / nloc;
        if (old + 1u == (gen + 1u) * nloc) {
            __builtin_amdgcn_fence(__ATOMIC_RELEASE, "agent");
            asm volatile("s_waitcnt vmcnt(0)" ::: "memory");
            const unsigned og = xb_add(&bar[XB_TOP], 1u);
            const unsigned tg = og / nx;
            if (og + 1u == (tg + 1u) * nx) xb_add(&bar[XB_TOPGEN], 1u);
            else XB_SPIN(xb_ld(&bar[XB_TOPGEN]) == tg, bar);
            __builtin_amdgcn_fence(__ATOMIC_ACQUIRE, "agent");
            xb_add(&bar[XB_XGEN(b.x)], 1u);
            asm volatile("s_waitcnt vmcnt(0)" ::: "memory");
        } else {
            XB_SPIN(xb_ld(&bar[XB_XGEN(b.x)]) == gen, bar);
            __builtin_amdgcn_fence(__ATOMIC_ACQUIRE, "agent");
            asm volatile("s_waitcnt vmcnt(0)" ::: "memory");
        }
    }
    __syncthreads();
}
constexpr int DMODEL = 1024, SEQ = 8192, NBATCH = 2, NMETA = 16, DB = 32, DS = 8, DFF = 2816, NPAGES = 64, PAGE = 128;
constexpr int R_MAIN = NBATCH * SEQ;
constexpr int R_SMALL = 288;
constexpr int R_ALL = R_MAIN + R_SMALL;
constexpr int NIN = 3072;
constexpr float RMS_EPS = 1e-6f, SUBLN_EPS = 1e-5f, LAMBDA_INIT = 0.2f;
constexpr float QSCALE = 0.125f * 1.4426950408889634f;
constexpr size_t OUT_YP = 0, OUT_YS = 16777216, OUT_KP = 17039360, OUT_VP = 25444352, OUT_CP = 33849344, OUT_KS = 33851392, OUT_VS = 33982464, OUT_CS = 34113536, OUT_TOTAL = 34146304;

constexpr size_t MiB = 1u << 20;
constexpr size_t WS_CTL = 0, CTL_ZERO_BYTES = 1 * MiB;
constexpr size_t WS_W1GU = 2 * MiB;
constexpr size_t WS_W1D = 14 * MiB;
constexpr size_t WS_WIN = 20 * MiB;
constexpr size_t WS_WOUT = 26 * MiB;
constexpr size_t WS_W2GU = 28 * MiB;
constexpr size_t WS_W2D = 40 * MiB;
constexpr size_t WS_XN = 48 * MiB;
constexpr size_t WS_H = 82 * MiB;
constexpr size_t WS_Y = 172 * MiB;
constexpr size_t WS_X1 = 238 * MiB;
constexpr size_t WS_QB = 304 * MiB;
constexpr size_t WS_KB = 320 * MiB;
constexpr size_t WS_KH = 336 * MiB;
constexpr size_t WS_VH = WS_KH + 131072;
constexpr size_t WS_VB = 337 * MiB;
constexpr size_t WS_GB = 354 * MiB;
constexpr size_t WS_UB = 370 * MiB;
constexpr size_t WS_O1 = 386 * MiB;
constexpr size_t WS_O2 = 402 * MiB;
constexpr size_t WS_PS = 418 * MiB;
constexpr size_t WS_PO = 422 * MiB;
constexpr size_t WS_PML = 438 * MiB;
constexpr size_t WS_END = 440 * MiB;
constexpr int CW_BAR = 4096;

constexpr int RING_OFF = 0, RING_BYTES = 131072;
constexpr int LDSCTL_OFF = RING_BYTES, MISC_OFF = LDSCTL_OFF + 320;
constexpr int LDS_BYTES = 147456;
constexpr int NWAVES = 8;

typedef float f32x16 __attribute__((ext_vector_type(16)));
typedef unsigned u32x2 __attribute__((ext_vector_type(2)));

__device__ __forceinline__ float wave_sum(float v) {
#pragma unroll
    for (int o = 1; o < 64; o <<= 1) v += __shfl_xor(v, o);
    return v;
}
__device__ __forceinline__ unsigned pkbf(float lo, float hi) { return pg8::cvt_pk_bf16(lo, hi); }
__device__ __forceinline__ float bf2f(unsigned short h) { return __uint_as_float(((unsigned)h) << 16); }
__device__ __forceinline__ bf16x8 pack8(f32x4 a, f32x4 b) { v4u w; w.x = pkbf(a[0], a[1]); w.y = pkbf(a[2], a[3]); w.z = pkbf(b[0], b[1]); w.w = pkbf(b[2], b[3]); return __builtin_bit_cast(bf16x8, w); }

struct Args {
    const float* in[27]; const int* page_table; float* out; unsigned char* ws; int ph_lo, ph_hi; int li, pad;
};

template <int MODE> __device__ __forceinline__ int wrow_map(int n0) {
    if (MODE == 0) return n0;
    if (MODE == 1) return 256 * (n0 >> 7) + (n0 & 127);
    if (MODE == 2) return 256 * (n0 >> 7) + 128 + (n0 & 127);
    if (n0 < 2048) return n0;
    if (n0 < 2560) { const int j = n0 - 2048; return 2048 + 256 * (j >> 7) + (j & 127); }
    { const int j = n0 - 2560; return 2048 + 256 * (j >> 7) + 128 + (j & 127); }
}
template <int MODE> __device__ __forceinline__ void p0_transpose_item(const float* W, int K, int N, bf16* WT, LAS float* scr, int item, int lane) {
    const int nblk = N / 32, kb = item / nblk, nb = item % nblk, k0 = 64 * kb, n0 = 32 * nb;
    const int r0 = wrow_map<MODE>(n0);
#pragma unroll 8
    for (int i = 0; i < 32; ++i) { const int kk = 2 * i + (lane >> 5); scr[kk * 33 + (lane & 31)] = W[(size_t)(k0 + kk) * N + n0 + (lane & 31)]; }
    LDS_WAIT(); asm volatile("" ::: "memory");
    const int c = lane & 7;
#pragma unroll
    for (int j = 0; j < 4; ++j) { const int n = (lane >> 3) + 8 * j; const LAS float* s = scr + (8 * c) * 33 + n;
        v4u o; o.x = pkbf(s[0 * 33], s[1 * 33]); o.y = pkbf(s[2 * 33], s[3 * 33]); o.z = pkbf(s[4 * 33], s[5 * 33]); o.w = pkbf(s[6 * 33], s[7 * 33]);
        *(GAS v4u*)(WT + (size_t)(r0 + n) * K + k0 + 8 * c) = o; }
    LDS_WAIT(); asm volatile("" ::: "memory");
}

__device__ __forceinline__ void store_bf16_row4(bf16* orow, int lane, int j, f32x4 v) {
    u32x2 w; w.x = pkbf(v[0], v[1]); w.y = pkbf(v[2], v[3]); *(u32x2*)(orow + 4 * lane + 256 * j) = w;
}
__device__ __forceinline__ void norm_row(const float* xrow, const float* g, bf16* orow, int lane) {
    f32x4 v[4]; float ss = 0.f;
#pragma unroll
    for (int j = 0; j < 4; ++j) { v[j] = xrow ? ((const f32x4*)xrow)[lane + 64 * j] : (f32x4){0.f, 0.f, 0.f, 0.f}; ss += (v[j][0] * v[j][0] + v[j][1] * v[j][1]) + (v[j][2] * v[j][2] + v[j][3] * v[j][3]); }
    const float rstd = rsqrtf(wave_sum(ss) * (1.0f / DMODEL) + RMS_EPS);
#pragma unroll
    for (int j = 0; j < 4; ++j) { const f32x4 gj = ((const f32x4*)g)[lane + 64 * j]; store_bf16_row4(orow, lane, j, v[j] * rstd * gj); }
}
__device__ __forceinline__ void norm_res_row(const float* yrow, const float* xi, const float* gpost, float c, float* xo, const float* gnext, bf16* xn, int lane) {
    f32x4 y[4], x[4]; float ss = 0.f;
#pragma unroll
    for (int j = 0; j < 4; ++j) { y[j] = ((const f32x4*)yrow)[lane + 64 * j]; x[j] = xi ? ((const f32x4*)xi)[lane + 64 * j] : (f32x4){0.f, 0.f, 0.f, 0.f};
        ss += (y[j][0] * y[j][0] + y[j][1] * y[j][1]) + (y[j][2] * y[j][2] + y[j][3] * y[j][3]); }
    const float k = c * rsqrtf(wave_sum(ss) * (1.0f / DMODEL) + RMS_EPS);
    float s2 = 0.f;
#pragma unroll
    for (int j = 0; j < 4; ++j) { const f32x4 gj = ((const f32x4*)gpost)[lane + 64 * j]; x[j] = x[j] + y[j] * k * gj;
        s2 += (x[j][0] * x[j][0] + x[j][1] * x[j][1]) + (x[j][2] * x[j][2] + x[j][3] * x[j][3]);
        if (xo) ((f32x4*)xo)[lane + 64 * j] = x[j]; }
    if (xn) { const float rstd = rsqrtf(wave_sum(s2) * (1.0f / DMODEL) + RMS_EPS);
#pragma unroll
        for (int j = 0; j < 4; ++j) { const f32x4 gj = ((const f32x4*)gnext)[lane + 64 * j]; store_bf16_row4(xn, lane, j, x[j] * rstd * gj); } }
}

template <int NB> __device__ __forceinline__ void sgemm_slice(const bf16* A, const bf16* B0, const bf16* B1, int K, int nblocks, f32x16 (&acc)[NB], int lane) {
    const int r = lane & 31, hi = lane >> 5;
    const bf16* ap = A + (size_t)r * K + 8 * hi; const bf16* bp0 = B0 + (size_t)r * K + 8 * hi; const bf16* bp1 = (NB > 1 ? B1 : B0) + (size_t)r * K + 8 * hi;
#pragma unroll
    for (int nb = 0; nb < NB; ++nb) acc[nb] = f32x16{};
    bf16x8 a[4], b0[4], b1[4];
#pragma unroll
    for (int s = 0; s < 4; ++s) { a[s] = *(const bf16x8*)(ap + 16 * s); b0[s] = *(const bf16x8*)(bp0 + 16 * s); if (NB > 1) b1[s] = *(const bf16x8*)(bp1 + 16 * s); }
    for (int bi = 1; bi <= nblocks; ++bi) {
        bf16x8 an[4], bn0[4], bn1[4];
        const int kn = bi < nblocks ? 64 * bi : 0;
#pragma unroll
        for (int s = 0; s < 4; ++s) { an[s] = *(const bf16x8*)(ap + kn + 16 * s); bn0[s] = *(const bf16x8*)(bp0 + kn + 16 * s); if (NB > 1) bn1[s] = *(const bf16x8*)(bp1 + kn + 16 * s); }
#pragma unroll
        for (int s = 0; s < 4; ++s) { acc[0] = __builtin_amdgcn_mfma_f32_32x32x16_bf16(a[s], b0[s], acc[0], 0, 0, 0); if (NB > 1) acc[NB - 1] = __builtin_amdgcn_mfma_f32_32x32x16_bf16(a[s], b1[s], acc[NB - 1], 0, 0, 0); }
#pragma unroll
        for (int s = 0; s < 4; ++s) { a[s] = an[s]; b0[s] = bn0[s]; if (NB > 1) b1[s] = bn1[s]; }
    }
}
__device__ __forceinline__ int crow16(int reg, int hi) { return (reg & 3) + 8 * (reg >> 2) + 4 * hi; }

template <int NB, class Epi> __device__ __forceinline__ void cu_tile(const bf16* A, const bf16* B0, const bf16* B1, int K, LAS float* red, int wave, const Epi& epi) {
    const int lane = threadIdx.x & 63, nblk = K / 64, base = nblk / 8, rem = nblk % 8;
    const int myb = base + (wave < rem ? 1 : 0), kb0 = 64 * (wave * base + (wave < rem ? wave : rem));
    f32x16 acc[NB];
    sgemm_slice<NB>(A + kb0, B0 + kb0, (NB > 1 ? B1 : B0) + kb0, K, myb, acc, lane);
#pragma unroll
    for (int nb = 0; nb < NB; ++nb)
#pragma unroll
        for (int reg = 0; reg < 16; ++reg) red[((wave * NB + nb) * 32 + crow16(reg, lane >> 5)) * 32 + (lane & 31)] = acc[nb][reg];
    __syncthreads();
#pragma unroll
    for (int i = 0; i < 2; ++i) { const int p = threadIdx.x + 512 * i; float v[NB];
#pragma unroll
        for (int nb = 0; nb < NB; ++nb) { float s = 0.f;
#pragma unroll
            for (int w = 0; w < 8; ++w) s += red[(w * NB + nb) * 1024 + p];
            v[nb] = s; }
        epi(p >> 5, p & 31, v); }
    __syncthreads();
}

__device__ __forceinline__ void sattn_item(int item, const float* PS, const float* ck, const float* cv, const int* pt, float* part_o, float* part_ml, int lane) {
    const int db = item >> 6, h = (item >> 4) & 3, ch = item & 15, g = lane >> 4, r = lane & 15;
    bf16x8 qf[4];
    { const int c = r >> 3, t = r & 7; const float* qrow = PS + (size_t)(NMETA + db * DS + t) * NIN + h * 128;
#pragma unroll
      for (int s = 0; s < 4; ++s) { const int cs = s >> 1; const float* qp = qrow + cs * 64 + 32 * (s & 1) + 4 * g;
          f32x4 lo = *(const f32x4*)qp, hi = *(const f32x4*)(qp + 16); if (c != cs) { lo = (f32x4){0.f, 0.f, 0.f, 0.f}; hi = lo; }
          qf[s] = pack8(lo * QSCALE, hi * QSCALE); } }
    float m = -INFINITY, lsum = 0.f; f32x4 O[8];
#pragma unroll
    for (int e = 0; e < 8; ++e) O[e] = (f32x4){0.f, 0.f, 0.f, 0.f};
    const f32x4 z4 = (f32x4){0.f, 0.f, 0.f, 0.f};
    for (int pi = 0; pi < 4; ++pi) {
        const int page = pt[db * NPAGES + ch * 4 + pi];
        const float* kp = ck + (size_t)page * (PAGE * 512) + h * 128 + (size_t)r * 512 + 4 * g;
        const float* vp = cv + (size_t)page * (PAGE * 512) + h * 128 + (size_t)(4 * g) * 512 + 4 * r;
#pragma unroll 1
        for (int sb = 0; sb < 8; ++sb) {
            f32x4 kl[8], vl[4][2];
#pragma unroll
            for (int i = 0; i < 8; ++i) kl[i] = __builtin_nontemporal_load((const f32x4*)(kp + 16 * i));
#pragma unroll
            for (int j = 0; j < 4; ++j)
#pragma unroll
                for (int hf = 0; hf < 2; ++hf) vl[j][hf] = __builtin_nontemporal_load((const f32x4*)(vp + j * 512 + 64 * hf));
            kp += 16 * 512; vp += 16 * 512;
            f32x4 S = z4;
#pragma unroll
            for (int s = 0; s < 4; ++s) S = __builtin_amdgcn_mfma_f32_16x16x32_bf16(pack8(kl[2 * s], kl[2 * s + 1]), qf[s], S, 0, 0, 0);
            float mx = fmaxf(fmaxf(S[0], S[1]), fmaxf(S[2], S[3]));
            mx = fmaxf(mx, __shfl_xor(mx, 16)); mx = fmaxf(mx, __shfl_xor(mx, 32));
            const float mn = fmaxf(m, mx), sc = __builtin_amdgcn_exp2f(m - mn); m = mn;
            f32x4 P;
#pragma unroll
            for (int i = 0; i < 4; ++i) P[i] = __builtin_amdgcn_exp2f(S[i] - mn);
            lsum = lsum * sc + ((P[0] + P[1]) + (P[2] + P[3]));
#pragma unroll
            for (int reg = 0; reg < 4; ++reg) { const float f = __shfl(sc, 4 * g + reg);
#pragma unroll
                for (int e = 0; e < 8; ++e) O[e][reg] *= f; }
            const bf16x8 pa = pack8(P, z4);
#pragma unroll
            for (int e = 0; e < 8; ++e) {
                f32x4 lo;
#pragma unroll
                for (int j = 0; j < 4; ++j) lo[j] = vl[j][e >> 2][e & 3];
                O[e] = __builtin_amdgcn_mfma_f32_16x16x32_bf16(pa, pack8(lo, z4), O[e], 0, 0, 0);
            }
        }
    }
    lsum += __shfl_xor(lsum, 16); lsum += __shfl_xor(lsum, 32);
    if (g == 0) { part_ml[(size_t)item * 32 + r] = m; part_ml[(size_t)item * 32 + 16 + r] = lsum; }
#pragma unroll
    for (int reg = 0; reg < 4; ++reg)
#pragma unroll
        for (int hf = 0; hf < 2; ++hf) { f32x4 o; o[0] = O[4 * hf + 0][reg]; o[1] = O[4 * hf + 1][reg]; o[2] = O[4 * hf + 2][reg]; o[3] = O[4 * hf + 3][reg];
            *(f32x4*)(part_o + ((size_t)item * 16 + 4 * g + reg) * 128 + 64 * hf + 4 * r) = o; }
}
__device__ __forceinline__ void unpack8(v4u w, float (&f)[8]) {
#pragma unroll
    for (int i = 0; i < 4; ++i) { const unsigned x = w[i]; f[2 * i] = __uint_as_float(x << 16); f[2 * i + 1] = __uint_as_float(x & 0xffff0000u); }
}
__device__ __forceinline__ v4u pack8f(const float (&f)[8]) { v4u w; w.x = pkbf(f[0], f[1]); w.y = pkbf(f[2], f[3]); w.z = pkbf(f[4], f[5]); w.w = pkbf(f[6], f[7]); return w; }
__device__ __forceinline__ void load8f(const float* p, float (&f)[8]) { const f32x4 a = *(const f32x4*)p, b = *(const f32x4*)(p + 4); f[0] = a[0]; f[1] = a[1]; f[2] = a[2]; f[3] = a[3]; f[4] = b[0]; f[5] = b[1]; f[6] = b[2]; f[7] = b[3]; }
__device__ __forceinline__ void small_u8(const float* PS, int q, int j0, float (&u)[8]) {
    const int n = 2048 + 256 * (j0 >> 7) + (j0 & 127); float a[8], b[8]; load8f(PS + (size_t)q * NIN + n, a); load8f(PS + (size_t)q * NIN + n + 128, b);
#pragma unroll
    for (int i = 0; i < 8; ++i) u[i] = a[i] * b[i];
}
__device__ __forceinline__ void subln_store(float (&o)[8], const float* subln_g, bf16* dst, int lane) {
    float ss = 0.f;
#pragma unroll
    for (int i = 0; i < 8; ++i) ss += o[i] * o[i];
    ss += __shfl_xor(ss, 1); ss += __shfl_xor(ss, 2); ss += __shfl_xor(ss, 4); ss += __shfl_xor(ss, 8);
    const float rstd = rsqrtf(ss * (1.0f / 128.0f) + SUBLN_EPS) * (1.0f - LAMBDA_INIT);
    float g[8]; load8f(subln_g + 8 * (lane & 15), g);
#pragma unroll
    for (int i = 0; i < 8; ++i) o[i] = o[i] * rstd * g[i];
    *(v4u*)dst = pack8f(o);
}
__device__ __forceinline__ void conv_store(const float (&gb)[8], const float (&u0)[8], const float (&u1)[8], const float (&u2)[8], const float* conv_w, int j0, bf16* dst) {
    float w0[8], w1[8], w2[8], c[8]; load8f(conv_w + j0, w0); load8f(conv_w + 512 + j0, w1); load8f(conv_w + 1024 + j0, w2);
#pragma unroll
    for (int i = 0; i < 8; ++i) c[i] = gb[i] * (w0[i] * u2[i] + w1[i] * u1[i] + w2[i] * u0[i]);
    *(v4u*)dst = pack8f(c);
}
__device__ __forceinline__ void combine_main_row(int row, float lam, const bf16* O1, const bf16* O2, const bf16* GB, const bf16* UB, const float* PS, const float* subln_g, const float* conv_w, bf16* AO, int lane) {
    const int s = row & (SEQ - 1), j0 = 8 * lane;
    float a[8], b[8];
    unpack8(*(const v4u*)(O1 + (size_t)row * 512 + j0), a); unpack8(*(const v4u*)(O2 + (size_t)row * 512 + j0), b);
#pragma unroll
    for (int i = 0; i < 8; ++i) a[i] = a[i] - lam * b[i];
    subln_store(a, subln_g, AO + (size_t)row * DMODEL + j0, lane);
    float gb[8], u0[8], u1[8], u2[8];
    unpack8(*(const v4u*)(GB + (size_t)row * 512 + j0), gb); unpack8(*(const v4u*)(UB + (size_t)row * 512 + j0), u0);
    if (s >= 1) unpack8(*(const v4u*)(UB + (size_t)(row - 1) * 512 + j0), u1); else small_u8(PS, 15, j0, u1);
    if (s >= 2) unpack8(*(const v4u*)(UB + (size_t)(row - 2) * 512 + j0), u2); else small_u8(PS, 14 + s, j0, u2);
    conv_store(gb, u0, u1, u2, conv_w, j0, AO + (size_t)row * DMODEL + 512 + j0);
}
__device__ __forceinline__ void combine_sample_row(int db, int t, float lam, const float* PS, const float* part_o, const float* part_ml, const float* state_conv, const float* subln_g, const float* conv_w, bf16* AO, float* out_cs, int lane) {
    const int h = lane >> 4, sub = lane & 15, e0 = 8 * sub, q = NMETA + db * DS + t;
    float a[8];
#pragma unroll 1
    for (int c = 0; c < 2; ++c) {
        const int col = c * 8 + t;
        float M = -INFINITY;
#pragma unroll 1
        for (int ch = 0; ch < 16; ++ch) M = fmaxf(M, part_ml[(size_t)((db * 4 + h) * 16 + ch) * 32 + col]);
        const f32x4 q4 = *(const f32x4*)(PS + (size_t)q * NIN + h * 128 + c * 64 + 4 * sub);
        float sn[8];
#pragma unroll
        for (int tp = 0; tp < 8; ++tp) { const f32x4 k4 = *(const f32x4*)(PS + (size_t)(NMETA + db * DS + tp) * NIN + 512 + h * 128 + c * 64 + 4 * sub);
            float d = (q4[0] * k4[0] + q4[1] * k4[1]) + (q4[2] * k4[2] + q4[3] * k4[3]);
            d += __shfl_xor(d, 1); d += __shfl_xor(d, 2); d += __shfl_xor(d, 4); d += __shfl_xor(d, 8);
            sn[tp] = (tp <= t) ? d * QSCALE : -INFINITY; M = fmaxf(M, sn[tp]); }
        float L = 0.f, acc[8];
#pragma unroll
        for (int i = 0; i < 8; ++i) acc[i] = 0.f;
#pragma unroll 2
        for (int ch = 0; ch < 16; ++ch) { const size_t item = (size_t)((db * 4 + h) * 16 + ch);
            const float w = __builtin_amdgcn_exp2f(part_ml[item * 32 + col] - M); L += part_ml[item * 32 + 16 + col] * w;
            float o[8]; load8f(part_o + (item * 16 + col) * 128 + e0, o);
#pragma unroll
            for (int i = 0; i < 8; ++i) acc[i] += w * o[i]; }
#pragma unroll
        for (int tp = 0; tp < 8; ++tp) { const float p = __builtin_amdgcn_exp2f(sn[tp] - M); L += p;
            float v[8]; load8f(PS + (size_t)(NMETA + db * DS + tp) * NIN + 1024 + h * 128 + e0, v);
#pragma unroll
            for (int i = 0; i < 8; ++i) acc[i] += p * v[i]; }
        const float inv = 1.0f / L;
#pragma unroll
        for (int i = 0; i < 8; ++i) a[i] = (c == 0) ? acc[i] * inv : a[i] - lam * acc[i] * inv;
    }
    const int row = R_MAIN + q, j0 = 8 * lane;
    subln_store(a, subln_g, AO + (size_t)row * DMODEL + j0, lane);
    float gb[8], u0[8], u1[8], u2[8];
    load8f(PS + (size_t)q * NIN + 1536 + j0, gb); small_u8(PS, q, j0, u0);
    if (t >= 1) small_u8(PS, q - 1, j0, u1); else load8f(state_conv + (size_t)(db * 2 + 1) * 512 + j0, u1);
    if (t >= 2) small_u8(PS, q - 2, j0, u2); else load8f(state_conv + (size_t)(db * 2 + t) * 512 + j0, u2);
    conv_store(gb, u0, u1, u2, conv_w, j0, AO + (size_t)row * DMODEL + 512 + j0);
    if (t >= 6) { float* o = out_cs + (size_t)(db * 2 + (t - 6)) * 512 + j0; *(f32x4*)o = (f32x4){u0[0], u0[1], u0[2], u0[3]}; *(f32x4*)(o + 4) = (f32x4){u0[4], u0[5], u0[6], u0[7]}; }
}

#ifndef MK_PROBE_PHASE
#define MK_PROBE_PHASE -1
#endif
constexpr int N_PHASES = 13;
typedef const __attribute__((address_space(4))) Args* KArgs;
#define PHASE_BEGIN(k) KArgs A_ = (KArgs)__builtin_amdgcn_kernarg_segment_ptr(); asm volatile("; PHASE_MARK " #k : "+s"(A_)); unsigned char* const ws = A_->ws; (void)ws
#define FRESH_LANE() int lane = threadIdx.x & 63; asm volatile("" : "+v"(lane))
#define WSP(T, off) ((T*)(ws + (off)))
__device__ __forceinline__ const float* x0_row(KArgs a, int row) {
    if (row < R_MAIN) return a->in[0] + (size_t)row * DMODEL;
    const int q = row - R_MAIN;
    if (q < NMETA) return a->in[6] + (size_t)q * DMODEL;
    if (q < NMETA + DB * DS) return a->in[1] + (size_t)(q - NMETA) * DMODEL;
    return nullptr;
}
__global__ void __launch_bounds__(NWAVES * 64, 2) fwd_kernel(Args args) {
    extern __shared__ __attribute__((aligned(16))) unsigned char lds[];
    LAS unsigned char* ldsl = (LAS unsigned char*)lds;
    volatile LAS unsigned* MISC = (volatile LAS unsigned*)(ldsl + MISC_OFF);
    const int wave = __builtin_amdgcn_readfirstlane(threadIdx.x >> 6);
    const int G = gridDim.x, bx = blockIdx.x, vcu = (G % 8 == 0) ? (bx % 8) * (G / 8) + bx / 8 : bx;
    for (int u = threadIdx.x; u < (LDS_BYTES - LDSCTL_OFF) / 4; u += NWAVES * 64) ((LAS unsigned*)(ldsl + LDSCTL_OFF))[u] = 0u;
    __syncthreads();
    XcdBarrier bar = xcd_barrier_post((unsigned*)(args.ws + WS_CTL) + CW_BAR + args.li * XCD_BAR_WORDS, MISC + 8);
#define GRID_BAR() xcd_barrier(bar)
#ifdef MK_FIXED_LO
    const int lo = MK_FIXED_LO, hi = MK_FIXED_HI;
#else
    const int lo = args.ph_lo, hi = args.ph_hi;
#endif
#define IN(k) (lo <= (k) && (k) < hi)
#define BOTH(k) (IN(k) && IN((k) + 1))
    const int gw = vcu * NWAVES + wave, NGW = G * NWAVES;
    const int cu = G - 1 - bx;

    if (IN(0)) { PHASE_BEGIN(0); FRESH_LANE();
        LAS float* scr = (LAS float*)(ldsl + RING_OFF + wave * 16384);
        constexpr int I_GU = 16 * 88, I_D = 44 * 32, I_IN = 16 * 96, I_O = 16 * 32;
        constexpr int NITEMS = 2 * (2 * I_GU + I_D) + I_IN + I_O;
        for (int it = gw; it < NITEMS; it += NGW) {
            int r = it;
            if (r < I_GU) { p0_transpose_item<1>(A_->in[8], DMODEL, DFF, WSP(bf16, WS_W1GU), scr, r, lane); continue; } r -= I_GU;
            if (r < I_GU) { p0_transpose_item<2>(A_->in[9], DMODEL, DFF, WSP(bf16, WS_W1GU), scr, r, lane); continue; } r -= I_GU;
            if (r < I_D) { p0_transpose_item<0>(A_->in[10], DFF, DMODEL, WSP(bf16, WS_W1D), scr, r, lane); continue; } r -= I_D;
            if (r < I_IN) { p0_transpose_item<3>(A_->in[13], DMODEL, NIN, WSP(bf16, WS_WIN), scr, r, lane); continue; } r -= I_IN;
            if (r < I_O) { p0_transpose_item<0>(A_->in[20], DMODEL, DMODEL, WSP(bf16, WS_WOUT), scr, r, lane); continue; } r -= I_O;
            if (r < I_GU) { p0_transpose_item<1>(A_->in[23], DMODEL, DFF, WSP(bf16, WS_W2GU), scr, r, lane); continue; } r -= I_GU;
            if (r < I_GU) { p0_transpose_item<2>(A_->in[24], DMODEL, DFF, WSP(bf16, WS_W2GU), scr, r, lane); continue; } r -= I_GU;
            p0_transpose_item<0>(A_->in[25], DFF, DMODEL, WSP(bf16, WS_W2D), scr, r, lane);
        }
        for (int row = gw; row < R_ALL; row += NGW) norm_row(x0_row(A_, row), A_->in[7], WSP(bf16, WS_XN) + (size_t)row * DMODEL, lane);
        for (int i = gw; i < 192; i += NGW) { const int buf = i / 96, b = (i % 96) / 48, rr = 16 + (i % 48);
            bf16* p = WSP(bf16, buf ? WS_VH : WS_KH) + (size_t)(b * 64 + rr) * 512 + 8 * lane; *(v4u*)p = (v4u){0u, 0u, 0u, 0u}; }
        if (BOTH(0)) GRID_BAR();
    }
#define FFN_UP(k, WOFF) do { PHASE_BEGIN(k); bf16* const XN = WSP(bf16, WS_XN); bf16* const WGU = WSP(bf16, WOFF); bf16* const HB = WSP(bf16, WS_H); \
        { pg8::Gemm g{XN, WGU, R_MAIN, 2 * DFF, DMODEL}; pg8::StaticOrder S; S.init(R_MAIN, 2 * DFF, G, bx); \
          pg8::EpiSwiGLU E{HB, DFF}; \
          pg8::gemm_phase<pg8::EpiSwiGLU, pg8::StaticOrder, true, true>(ldsl + RING_OFF, g, S, E); } \
        if (cu < 128) for (int tile = cu; tile < 9 * 88; tile += 128) { const int rb = tile % 9, cb = tile / 9, grow = 256 * (cb >> 2) + 32 * (cb & 3); \
            cu_tile<2>(XN + (size_t)(R_MAIN + 32 * rb) * DMODEL, WGU + (size_t)grow * DMODEL, WGU + (size_t)(grow + 128) * DMODEL, DMODEL, (LAS float*)(ldsl + RING_OFF), wave, \
                [=](int row, int col, const float (&v)[2]) { HB[(size_t)(R_MAIN + 32 * rb + row) * DFF + 32 * cb + col] = (bf16)(pkbf(pg8::silu_f(v[0]) * v[1], 0.f) & 0xffffu); }); } \
    } while (0)
    if (IN(1)) { FFN_UP(1, WS_W1GU); if (BOTH(1)) GRID_BAR(); }
#define FFN_DOWN(k, WOFF) do { PHASE_BEGIN(k); bf16* const HB = WSP(bf16, WS_H); bf16* const WD = WSP(bf16, WOFF); float* const Y = WSP(float, WS_Y); \
        { pg8::Gemm g{HB, WD, R_MAIN, DMODEL, DFF}; pg8::StaticOrder S; S.init(R_MAIN, DMODEL, G, bx); \
          pg8::EpiF32 E{Y, DMODEL}; \
          pg8::gemm_phase<pg8::EpiF32, pg8::StaticOrder, false, true>(ldsl + RING_OFF, g, S, E); } \
        for (int tile = cu; tile < 9 * 16; tile += G) { const int rb = tile % 9, cb = tile / 9; \
            cu_tile<2>(HB + (size_t)(R_MAIN + 32 * rb) * DFF, WD + (size_t)(64 * cb) * DFF, WD + (size_t)(64 * cb + 32) * DFF, DFF, (LAS float*)(ldsl + RING_OFF), wave, \
                [=](int row, int col, const float (&v)[2]) { float* y = Y + (size_t)(R_MAIN + 32 * rb + row) * DMODEL + 64 * cb + col; y[0] = v[0]; y[32] = v[1]; }); } \
    } while (0)
    if (IN(2)) { FFN_DOWN(2, WS_W1D); if (BOTH(2)) GRID_BAR(); }
    if (IN(3)) { PHASE_BEGIN(3); FRESH_LANE();
        for (int row = gw; row < R_ALL; row += NGW) norm_res_row(WSP(float, WS_Y) + (size_t)row * DMODEL, x0_row(A_, row), A_->in[11], 0.5f, WSP(float, WS_X1) + (size_t)row * DMODEL, A_->in[12], WSP(bf16, WS_XN) + (size_t)row * DMODEL, lane);
        if (BOTH(3)) GRID_BAR();
    }
    if (IN(4)) { PHASE_BEGIN(4); bf16* const XN = WSP(bf16, WS_XN); bf16* const WIN = WSP(bf16, WS_WIN); bf16* const KB = WSP(bf16, WS_KB); bf16* const VB = WSP(bf16, WS_VB); bf16* const KH = WSP(bf16, WS_KH); bf16* const VH = WSP(bf16, WS_VH); float* const out = A_->out;
        { pg8::Gemm g{XN, WIN, R_MAIN, NIN, DMODEL}; pg8::StaticOrder S; S.init(R_MAIN, NIN, G, bx);
          pg8::EpiWin E{WSP(bf16, WS_QB), KB, VB, WSP(bf16, WS_GB), WSP(bf16, WS_UB), out + OUT_KP, out + OUT_VP, out + OUT_CP, QSCALE};
          pg8::gemm_phase<pg8::EpiWin, pg8::StaticOrder, true, true>(ldsl + RING_OFF, g, S, E); }
        float* const PS = WSP(float, WS_PS);
        for (int tile = cu; tile < 9 * 48; tile += G) { const int rb = tile % 9, cb = tile / 9;
            cu_tile<2>(XN + (size_t)(R_MAIN + 32 * rb) * DMODEL, WIN + (size_t)(64 * cb) * DMODEL, WIN + (size_t)(64 * cb + 32) * DMODEL, DMODEL, (LAS float*)(ldsl + RING_OFF), wave,
                [=](int row, int col, const float (&v)[2]) { const int i = 32 * rb + row;
#pragma unroll
                    for (int nb = 0; nb < 2; ++nb) { const int n0 = 64 * cb + 32 * nb, n = n0 + col; const float x = v[nb];
                        PS[(size_t)i * NIN + n] = x;
                        if (n0 >= 512 && n0 < 1536) { const bool isk = n0 < 1024; const int cc = n - (isk ? 512 : 1024);
                            if (i < NMETA) { const bf16 hv = (bf16)(pkbf(x, 0.f) & 0xffffu);
#pragma unroll
                                for (int b = 0; b < NBATCH; ++b) { (isk ? KH : VH)[(size_t)(b * 64 + i) * 512 + cc] = hv; (out + (isk ? OUT_KP : OUT_VP))[(size_t)(b * (NMETA + SEQ) + i) * 512 + cc] = x; } }
                            else if (i < NMETA + DB * DS) (out + (isk ? OUT_KS : OUT_VS))[(size_t)(i - NMETA) * 512 + cc] = x; } } }); }
        if (BOTH(4)) GRID_BAR();
    }
    if (IN(5)) {
        { PHASE_BEGIN(5);
          const attn_body::AttnTensors AT{WSP(const attn_body::bf16, WS_QB), WSP(const attn_body::bf16, WS_KB), WSP(const attn_body::bf16, WS_VB), WSP(const attn_body::bf16, WS_KH), WSP(const attn_body::bf16, WS_VH), WSP(attn_body::bf16, WS_O1), WSP(attn_body::bf16, WS_O2)};
          const attn_body::StaticOrder S((int)G, (int)bx);
          attn_body::attn_phase<attn_body::StaticOrder>((char*)lds + RING_OFF, AT, S); }
    }
    if (IN(6)) { PHASE_BEGIN(6); FRESH_LANE();
        for (int item = gw; item < DB * 4 * 16; item += NGW) sattn_item(item, WSP(float, WS_PS), A_->in[2], A_->in[3], A_->page_table, WSP(float, WS_PO), WSP(float, WS_PML), lane);
        if (BOTH(6)) GRID_BAR();
    }
    if (IN(7)) { PHASE_BEGIN(7); FRESH_LANE();
        const float l1 = wave_sum(A_->in[14][lane] * A_->in[15][lane]), l2 = wave_sum(A_->in[16][lane] * A_->in[17][lane]);
        const float lam = expf(l1) - expf(l2) + LAMBDA_INIT;
        for (int row = gw; row < R_MAIN; row += NGW) combine_main_row(row, lam, WSP(bf16, WS_O1), WSP(bf16, WS_O2), WSP(bf16, WS_GB), WSP(bf16, WS_UB), WSP(float, WS_PS), A_->in[18], A_->in[19], WSP(bf16, WS_XN), lane);
        for (int q = NGW - 1 - gw; q < DB * DS; q += NGW) combine_sample_row(q >> 3, q & 7, lam, WSP(float, WS_PS), WSP(float, WS_PO), WSP(float, WS_PML), A_->in[4], A_->in[18], A_->in[19], WSP(bf16, WS_XN), A_->out + OUT_CS, lane);
        if (BOTH(7)) GRID_BAR();
    }
    if (IN(8)) { PHASE_BEGIN(8); bf16* const XN = WSP(bf16, WS_XN); bf16* const WOUT = WSP(bf16, WS_WOUT); float* const Y = WSP(float, WS_Y);
        { pg8::Gemm g{XN, WOUT, R_MAIN, DMODEL, DMODEL}; pg8::StaticOrder S; S.init(R_MAIN, DMODEL, G, bx);
          pg8::EpiF32 E{Y, DMODEL};
          pg8::gemm_phase<pg8::EpiF32, pg8::StaticOrder, false, true>(ldsl + RING_OFF, g, S, E); }
        for (int tile = cu; tile < 9 * 16; tile += G) { const int rb = tile % 9, cb = tile / 9;
            cu_tile<2>(XN + (size_t)(R_MAIN + 32 * rb) * DMODEL, WOUT + (size_t)(64 * cb) * DMODEL, WOUT + (size_t)(64 * cb + 32) * DMODEL, DMODEL, (LAS float*)(ldsl + RING_OFF), wave,
                [=](int row, int col, const float (&v)[2]) { float* y = Y + (size_t)(R_MAIN + 32 * rb + row) * DMODEL + 64 * cb + col; y[0] = v[0]; y[32] = v[1]; }); }
        if (BOTH(8)) GRID_BAR();
    }
    if (IN(9)) { PHASE_BEGIN(9); FRESH_LANE();
        for (int row = gw; row < R_ALL; row += NGW) norm_res_row(WSP(float, WS_Y) + (size_t)row * DMODEL, WSP(float, WS_X1) + (size_t)row * DMODEL, A_->in[21], 1.0f, WSP(float, WS_X1) + (size_t)row * DMODEL, A_->in[22], WSP(bf16, WS_XN) + (size_t)row * DMODEL, lane);
        if (BOTH(9)) GRID_BAR();
    }
    if (IN(10)) { FFN_UP(10, WS_W2GU); if (BOTH(10)) GRID_BAR(); }
    if (IN(11)) { FFN_DOWN(11, WS_W2D); if (BOTH(11)) GRID_BAR(); }
    if (IN(12)) { PHASE_BEGIN(12); FRESH_LANE(); float* const out = A_->out;
        for (int row = gw; row < R_MAIN + NMETA + DB * DS; row += NGW) {
            float* o = row < R_MAIN ? out + OUT_YP + (size_t)row * DMODEL : (row >= R_MAIN + NMETA ? out + OUT_YS + (size_t)(row - R_MAIN - NMETA) * DMODEL : nullptr);
            if (o) norm_res_row(WSP(float, WS_Y) + (size_t)row * DMODEL, WSP(float, WS_X1) + (size_t)row * DMODEL, A_->in[26], 0.5f, o, nullptr, nullptr, lane);
        }
    }
#undef IN
#undef BOTH
}

extern "C" void kernel_launch(void* const* d_in, const int* in_sizes, int n_in, void* d_out, int out_size, void* d_ws, size_t ws_size, hipStream_t stream) {
    static int grid = 0;
    if (grid == 0) {
        if (n_in != 27 || (size_t)out_size != OUT_TOTAL || ws_size < WS_END) { fprintf(stderr, "kernel_launch: unexpected shapes (n_in %d out %d ws %zu)\n", n_in, out_size, ws_size); grid = -1; return; }
        int dev = 0, cus = 0, per_cu = 0;
        if (hipGetDevice(&dev) != hipSuccess || hipDeviceGetAttribute(&cus, hipDeviceAttributeMultiprocessorCount, dev) != hipSuccess) { grid = -1; return; }
        if (hipFuncSetAttribute((const void*)fwd_kernel, hipFuncAttributeMaxDynamicSharedMemorySize, LDS_BYTES) != hipSuccess) { fprintf(stderr, "kernel_launch: hipFuncSetAttribute failed\n"); grid = -1; return; }
        if (hipOccupancyMaxActiveBlocksPerMultiprocessor(&per_cu, (const void*)fwd_kernel, NWAVES * 64, LDS_BYTES) != hipSuccess || per_cu < 1) fprintf(stderr, "kernel_launch: occupancy query says %d\n", per_cu);
        (void)hipGetLastError();
        grid = cus;
    }
    if (grid < 0) return;
    (void)hipMemsetAsync((char*)d_ws + WS_CTL, 0, CTL_ZERO_BYTES, stream);
    Args a{};
    for (int i = 0; i < 27; ++i) a.in[i] = (const float*)d_in[i];
    a.page_table = (const int*)d_in[5]; a.out = (float*)d_out; a.ws = (unsigned char*)d_ws;
#if MK_PROBE_PHASE >= 0
    const int plan[3][2] = {{0, MK_PROBE_PHASE + 1}, {MK_PROBE_PHASE, MK_PROBE_PHASE + 1}, {MK_PROBE_PHASE + 1, N_PHASES}}; const int nl = (MK_PROBE_PHASE + 1 < N_PHASES) ? 3 : 2;
#else
    const int plan[1][2] = {{0, N_PHASES}}; const int nl = 1;
#endif
    for (int li = 0; li < nl; ++li) {
        a.ph_lo = plan[li][0]; a.ph_hi = plan[li][1]; a.li = li; a.pad = 0;
        hipLaunchKernelGGL(fwd_kernel, dim3(grid), dim3(NWAVES * 64), LDS_BYTES, stream, a);
    }
}
```
